# Optimizing an MI355X kernel written in HIP

```python
import math
import jax, jax.numpy as jnp
from jax import lax
import numpy as np

D_MODEL = 1024
BATCH = 4
SEQ = 8192
DEPTH = 1

GRID_W = 64
N_META = 16
NA_HEADS = 8
NA_HEAD_DIM = 64
NA_WIN_ROWS = 8
NA_WIN_COLS = 16
DIFF_HEADS = 4
DIFF_HEAD_DIM = 64
NA_WIDTH = NA_HEADS * NA_HEAD_DIM
DIFF_WIDTH = DIFF_HEADS * 2 * DIFF_HEAD_DIM
N_BRANCH = 2
IN_SPLITS = (NA_WIDTH, NA_WIDTH, NA_WIDTH, DIFF_WIDTH, DIFF_WIDTH, DIFF_WIDTH, D_MODEL, D_MODEL)
IN_COLS = sum(IN_SPLITS)
D_FF = -(-(8 * D_MODEL) // (3 * 256)) * 256
Q_BLOCK = 128
ROPE_THETA = 10000.0
NORM_EPS = 1e-6
SUBLN_EPS = 1e-5

kernel_name = "hybrid_natten_diffattn_gated_block"


def rmsnorm(x, g, eps=NORM_EPS):
    xf = x.astype(jnp.float32)
    y = xf * lax.rsqrt(jnp.mean(xf * xf, axis=-1, keepdims=True) + eps)
    return (y * g.astype(jnp.float32)).astype(x.dtype)


def rope(x, pos):
    d = x.shape[-1]
    half = d // 2
    inv = ROPE_THETA ** (-jnp.arange(half, dtype=jnp.float32) / half)
    ang = pos.astype(jnp.float32)[:, None] * inv[None, :]
    shp = (1, pos.shape[0]) + (1,) * (x.ndim - 3) + (half,)
    cos = jnp.cos(ang).reshape(shp)
    sin = jnp.sin(ang).reshape(shp)
    xf = x.astype(jnp.float32)
    x1, x2 = xf[..., :half], xf[..., half:]
    return jnp.concatenate([x1 * cos - x2 * sin, x2 * cos + x1 * sin], axis=-1).astype(x.dtype)


def neighbourhood_attention(q, k, v, rpb):
    B, L, H, d = q.shape
    T = L - N_META
    rows = T // GRID_W
    kr = min(NA_WIN_ROWS, rows)
    kc = NA_WIN_COLS
    scale = d ** -0.5
    qm, km, vm = q[:, :N_META], k[:, :N_META], v[:, :N_META]
    kg = k[:, N_META:].reshape(B, rows, GRID_W, H, d)
    vg = v[:, N_META:].reshape(B, rows, GRID_W, H, d)
    qg = q[:, N_META:].reshape(B, rows, GRID_W, H, d)

    s_mm = jnp.einsum('bqhd,bkhd->bhqk', qm, km).astype(jnp.float32) * scale
    p_mm = jax.nn.softmax(s_mm, axis=-1).astype(v.dtype)
    out_meta = jnp.einsum('bhqk,bkhd->bqhd', p_mm, vm)

    cols = jnp.arange(GRID_W)
    col_start = jnp.clip(cols - kc // 2, 0, GRID_W - kc)
    col_idx = col_start[:, None] + jnp.arange(kc)[None, :]
    col_bias_idx = col_idx - cols[:, None] + (NA_WIN_COLS - 1)
    bias_c = rpb.astype(jnp.float32)

    def row_fn(args):
        r, q_row = args
        rs = jnp.clip(r - kr // 2, 0, rows - kr)
        k_rows = lax.dynamic_slice_in_dim(kg, rs, kr, axis=1)
        v_rows = lax.dynamic_slice_in_dim(vg, rs, kr, axis=1)
        k_win = k_rows[:, :, col_idx]
        v_win = v_rows[:, :, col_idx]
        s_win = jnp.einsum('bwhd,biwjhd->bhwij', q_row, k_win).astype(jnp.float32) * scale
        row_bias_idx = rs + jnp.arange(kr) - r + (NA_WIN_ROWS - 1)
        bias = bias_c[:, row_bias_idx[None, :, None], col_bias_idx[:, None, :]]
        s_win = (s_win + bias[None]).reshape(B, H, GRID_W, kr * kc)
        s_meta = jnp.einsum('bwhd,bkhd->bhwk', q_row, km).astype(jnp.float32) * scale
        p = jax.nn.softmax(jnp.concatenate([s_win, s_meta], axis=-1), axis=-1).astype(v.dtype)
        p_win = p[..., :kr * kc].reshape(B, H, GRID_W, kr, kc)
        p_meta = p[..., kr * kc:]
        return (jnp.einsum('bhwij,biwjhd->bwhd', p_win, v_win)
                + jnp.einsum('bhwk,bkhd->bwhd', p_meta, vm))

    out_rows = lax.map(row_fn, (jnp.arange(rows), jnp.moveaxis(qg, 1, 0)))
    out_grid = jnp.moveaxis(out_rows, 0, 1).reshape(B, T, H, d)
    return jnp.concatenate([out_meta, out_grid], axis=1)


def diff_attention(q, k, v, lam, lambda_init, subln_g):
    B, L, H, _, d = q.shape
    T = L - N_META
    scale = d ** -0.5

    def attend(q_blk):
        s = jnp.einsum('bqhcd,bkhcd->bhcqk', q_blk, k).astype(jnp.float32) * scale
        p = jax.nn.softmax(s, axis=-1)
        a = p[:, :, 0] - lam * p[:, :, 1]
        return jnp.einsum('bhqk,bkhe->bqhe', a.astype(v.dtype), v)

    out_meta = attend(q[:, :N_META])
    q_blocks = jnp.moveaxis(q[:, N_META:].reshape(B, T // Q_BLOCK, Q_BLOCK, H, 2, d), 1, 0)
    out_real = lax.map(attend, q_blocks)
    out_real = jnp.moveaxis(out_real, 0, 1).reshape(B, T, H, 2 * d)
    o = jnp.concatenate([out_meta, out_real], axis=1)
    return rmsnorm(o, subln_g, SUBLN_EPS) * (1.0 - lambda_init)


def hybrid_layer(x, pos, layer_idx, mix_norm, w_in, na_rpb, lambda_q1, lambda_k1, lambda_q2,
                 lambda_k2, diff_subln, w_na_out, w_diff_out, w_o, ffn_norm, w_gate, w_up, w_down):
    B, L, _ = x.shape
    h = rmsnorm(x, mix_norm)
    proj = h @ w_in
    na_q, na_k, na_v, df_q, df_k, df_v, g_na, g_df = jnp.split(
        proj, list(np.cumsum(IN_SPLITS)[:-1]), axis=-1)

    na_out = neighbourhood_attention(
        na_q.reshape(B, L, NA_HEADS, NA_HEAD_DIM),
        na_k.reshape(B, L, NA_HEADS, NA_HEAD_DIM),
        na_v.reshape(B, L, NA_HEADS, NA_HEAD_DIM), na_rpb)
    o_na = na_out.reshape(B, L, NA_WIDTH) @ w_na_out

    lambda_init = 0.8 - 0.6 * math.exp(-0.3 * layer_idx)
    lam = (jnp.exp(jnp.sum(lambda_q1.astype(jnp.float32) * lambda_k1.astype(jnp.float32)))
           - jnp.exp(jnp.sum(lambda_q2.astype(jnp.float32) * lambda_k2.astype(jnp.float32)))
           + lambda_init)
    dq = rope(df_q.reshape(B, L, DIFF_HEADS, 2, DIFF_HEAD_DIM), pos)
    dk = rope(df_k.reshape(B, L, DIFF_HEADS, 2, DIFF_HEAD_DIM), pos)
    dv = df_v.reshape(B, L, DIFF_HEADS, 2 * DIFF_HEAD_DIM)
    df_out = diff_attention(dq, dk, dv, lam, lambda_init, diff_subln)
    o_df = df_out.reshape(B, L, DIFF_WIDTH) @ w_diff_out

    merged = jax.nn.sigmoid(g_na) * o_na + jax.nn.sigmoid(g_df) * o_df
    x = x + merged @ w_o

    h = rmsnorm(x, ffn_norm)
    x = x + (jax.nn.silu(h @ w_gate) * (h @ w_up)) @ w_down
    return x


def setup_inputs(seed: int = 0) -> dict:
    key = jax.random.key(seed)
    ks = jax.random.split(key, 20)
    f32 = jnp.float32

    def nrm(k, shape, scale):
        return jax.random.normal(k, shape, f32) * scale

    return {
        "x": nrm(ks[0], (BATCH, SEQ, D_MODEL), 1.0),
        "meta_tokens": nrm(ks[1], (N_META, D_MODEL), 1.0),
        "mix_norm": 1.0 + nrm(ks[2], (DEPTH, D_MODEL), 0.02),
        "w_in": nrm(ks[3], (DEPTH, D_MODEL, IN_COLS), D_MODEL ** -0.5),
        "na_rpb": nrm(ks[4], (DEPTH, NA_HEADS, 2 * NA_WIN_ROWS - 1, 2 * NA_WIN_COLS - 1), 0.1),
        "lambda_q1": nrm(ks[5], (DEPTH, DIFF_HEAD_DIM), 0.1),
        "lambda_k1": nrm(ks[6], (DEPTH, DIFF_HEAD_DIM), 0.1),
        "lambda_q2": nrm(ks[7], (DEPTH, DIFF_HEAD_DIM), 0.1),
        "lambda_k2": nrm(ks[8], (DEPTH, DIFF_HEAD_DIM), 0.1),
        "diff_subln": 1.0 + nrm(ks[9], (DEPTH, 2 * DIFF_HEAD_DIM), 0.02),
        "w_na_out": nrm(ks[10], (DEPTH, NA_WIDTH, D_MODEL), NA_WIDTH ** -0.5),
        "w_diff_out": nrm(ks[11], (DEPTH, DIFF_WIDTH, D_MODEL), DIFF_WIDTH ** -0.5),
        "w_o": nrm(ks[12], (DEPTH, D_MODEL, D_MODEL), D_MODEL ** -0.5),
        "ffn_norm": 1.0 + nrm(ks[13], (DEPTH, D_MODEL), 0.02),
        "w_gate": nrm(ks[14], (DEPTH, D_MODEL, D_FF), D_MODEL ** -0.5),
        "w_up": nrm(ks[15], (DEPTH, D_MODEL, D_FF), D_MODEL ** -0.5),
        "w_down": nrm(ks[16], (DEPTH, D_FF, D_MODEL), D_FF ** -0.5),
        "final_norm": 1.0 + nrm(ks[17], (D_MODEL,), 0.02),
    }


def reference(x, meta_tokens, mix_norm, w_in, na_rpb, lambda_q1, lambda_k1, lambda_q2, lambda_k2,
              diff_subln, w_na_out, w_diff_out, w_o, ffn_norm, w_gate, w_up, w_down, final_norm):
    B = x.shape[0]
    meta = jnp.broadcast_to(meta_tokens[None].astype(x.dtype), (B, N_META, D_MODEL))
    h = jnp.concatenate([meta, x], axis=1)
    pos = jnp.arange(h.shape[1], dtype=jnp.int32)
    for l in range(DEPTH):
        h = hybrid_layer(h, pos, l, mix_norm[l], w_in[l], na_rpb[l], lambda_q1[l], lambda_k1[l],
                         lambda_q2[l], lambda_k2[l], diff_subln[l], w_na_out[l], w_diff_out[l],
                         w_o[l], ffn_norm[l], w_gate[l], w_up[l], w_down[l])
    h = rmsnorm(h, final_norm)
    return h[:, N_META:]
```

```cpp
#include <hip/hip_runtime.h>
#include <hip/hip_cooperative_groups.h>
#include <cstdio>
#include <cstdint>
namespace cg = cooperative_groups;

#define LAS __attribute__((address_space(3)))
typedef unsigned short bf16_t;
typedef short bf16x8 __attribute__((ext_vector_type(8)));
typedef float f32x4 __attribute__((ext_vector_type(4)));
typedef float f32x2 __attribute__((ext_vector_type(2)));
typedef float f32x16 __attribute__((ext_vector_type(16)));
typedef unsigned u32x4 __attribute__((ext_vector_type(4)));
typedef unsigned u32x2 __attribute__((ext_vector_type(2)));
typedef __bf16 bf16x2_t __attribute__((ext_vector_type(2)));

constexpr int DM = 1024, NB = 4, SEQ = 8192, MTOK = NB * SEQ;
constexpr int NMETA = 16, DFF = 2816, INCOLS = 5120;
constexpr float C2 = 0.125f * 1.4426950408889634f;
constexpr float LOG2E = 1.4426950408889634f;

constexpr size_t MiB = (size_t)1 << 20;
constexpr size_t WS_WINA = 0;
constexpr size_t WS_WINV = 8 * MiB;
constexpr size_t WS_WM = 10 * MiB;
constexpr size_t WS_WO = 12 * MiB;
constexpr size_t WS_WGU = 14 * MiB;
constexpr size_t WS_WD = 25 * MiB;
constexpr size_t WS_ROPEC = 31 * MiB;
constexpr size_t WS_ROPES = 32 * MiB + 512 * 1024;
constexpr size_t WS_NAKM = 34 * MiB;
constexpr size_t WS_DFKM = WS_NAKM + 64 * 1024;
constexpr size_t WS_NAVTM = WS_DFKM + 128 * 1024;
constexpr size_t WS_DFVTM = WS_NAVTM + 64 * 1024;
constexpr size_t WS_XN = 36 * MiB;
constexpr size_t WS_NAQ = 100 * MiB, WS_NAK = 132 * MiB, WS_DFQ = 164 * MiB, WS_DFK = 196 * MiB;
constexpr size_t WS_VT = 228 * MiB;
constexpr size_t WS_ACT = 100 * MiB;
constexpr size_t WS_GNA = 292 * MiB, WS_GDF = 356 * MiB;
constexpr size_t WS_AO = 420 * MiB;
constexpr size_t WS_CTL = 484 * MiB, CTL_BYTES = 64 * 1024;
constexpr size_t WS_RSTD = 485 * MiB;
constexpr size_t WS_END = 486 * MiB;

namespace pg8 {
constexpr int BM = 256, BK = 64, HALF = 128, HTB = HALF * BK * 2, STAGE_BYTES = 8 * HTB, NXCD = 8, WGM = 8;
__host__ __device__ __forceinline__ int lds_byte(int r, int c) { const int st = (r >> 4) * 2 + (c >> 5), rr = r & 15, cc = c & 31, ob = rr * 64 + cc * 2; return st * 1024 + (ob ^ (((ob >> 9) & 1) << 5)); }
__host__ __device__ __forceinline__ void stage_rc(int b, int& R, int& C) { const int st = b / 1024, sb = b % 1024, swz = sb ^ (((sb >> 9) & 1) << 5); R = (st >> 1) * 16 + swz / 64; C = (st & 1) * 32 + (swz % 64) / 2; }
__host__ __device__ __forceinline__ int perm32(int rho) { const int n = rho >> 4, i = rho & 15; return 8 * (i >> 2) + 4 * n + (i & 3); }

struct Unit { int pm, pn; };
struct Gemm { const bf16_t* A; const bf16_t* Bt; int M, N, K; };

struct StaticOrder {
    int nM, nN, nwg, G, c;
    __host__ __device__ void init(int M, int N, int G_, int c_) { nM = M / BM; nN = N / BM; nwg = nM * nN; G = G_; c = c_; }
    __host__ __device__ bool next(int i, Unit& u) const {
        const long L = (long)i * G + c; if (L >= nwg) return false;
        int wgid = (int)L; { const int q = nwg / NXCD, r = nwg % NXCD, xcd = wgid % NXCD, off = wgid / NXCD; wgid = (xcd < r ? xcd * (q + 1) : r * (q + 1) + (xcd - r) * q) + off; }
        const int nig = WGM * nN, gid = wgid / nig, fm = gid * WGM, gsz = (nM - fm) < WGM ? (nM - fm) : WGM;
        u.pm = fm + ((wgid % nig) % gsz); u.pn = (wgid % nig) / gsz; return true;
    }
};

__device__ __forceinline__ unsigned cvt_pk_bf16(float lo, float hi) { f32x2 v = {lo, hi}; bf16x2_t b = __builtin_convertvector(v, bf16x2_t); return __builtin_bit_cast(unsigned, b); }
__device__ __forceinline__ float bf_lo(unsigned w) { return __uint_as_float(w << 16); }
__device__ __forceinline__ float bf_hi(unsigned w) { return __uint_as_float(w & 0xffff0000u); }
__device__ __forceinline__ float sigmoidf_fast(float x) { return __builtin_amdgcn_rcpf(1.0f + __builtin_amdgcn_exp2f(-x * LOG2E)); }


struct EpiBf16 {
    static constexpr bool PERM = true, HAS_MID = false;
    bf16_t* O; int ldc;
    __device__ __forceinline__ void mid(f32x4 (&)[2][2][4][2], const Unit&, int, int, int, int) const {}
    __device__ __forceinline__ void operator()(const f32x4 (&acc)[2][2][4][2], const Unit& u, int wr, int wc, int fr, int fq) const {
        const int row0 = u.pm * BM + wr * 64 + fr, col0 = u.pn * BM + wc * 32 + 8 * fq;
#pragma unroll
        for (int ai = 0; ai < 2; ++ai)
#pragma unroll
            for (int m = 0; m < 4; ++m) { bf16_t* rowp = O + (size_t)(row0 + ai * HALF + m * 16) * ldc + col0;
#pragma unroll
                for (int bj = 0; bj < 2; ++bj) { const f32x4 v0 = acc[ai][bj][m][0], v1 = acc[ai][bj][m][1];
                    u32x4 w; w.x = cvt_pk_bf16(v0[0], v0[1]); w.y = cvt_pk_bf16(v0[2], v0[3]); w.z = cvt_pk_bf16(v1[0], v1[1]); w.w = cvt_pk_bf16(v1[2], v1[3]);
                    *(u32x4*)(rowp + bj * HALF) = w; } }
    }
};

struct EpiVT {
    static constexpr bool PERM = true, HAS_MID = false;
    bf16_t* VT;
    __device__ __forceinline__ void mid(f32x4 (&)[2][2][4][2], const Unit&, int, int, int, int) const {}
    __device__ __forceinline__ void operator()(const f32x4 (&acc)[2][2][4][2], const Unit& u, int wr, int wc, int fr, int fq) const {
        const int ch0 = u.pm * BM + wr * 64 + fr, tok0 = u.pn * BM + wc * 32 + 8 * fq;
#pragma unroll
        for (int ai = 0; ai < 2; ++ai)
#pragma unroll
            for (int m = 0; m < 4; ++m) { const int ch = ch0 + ai * HALF + m * 16;
#pragma unroll
                for (int bj = 0; bj < 2; ++bj) { const int tok = tok0 + bj * HALF; const int b = tok >> 13, blk = (tok >> 6) & 127, k = tok & 63;
                    size_t off;
                    if (ch < 512) off = (size_t)((b * 8 + (ch >> 6)) * 128 + blk) * 4096 + (k >> 4) * 1024 + (ch & 63) * 16 + (k & 15);
                    else { const int c2 = ch - 512; off = (size_t)16777216 + ((size_t)((b * 4 + (c2 >> 7)) * 128 + blk) * 128 + (c2 & 127)) * 64 + k; }
                    const f32x4 v0 = acc[ai][bj][m][0], v1 = acc[ai][bj][m][1];
                    u32x4 w; w.x = cvt_pk_bf16(v0[0], v0[1]); w.y = cvt_pk_bf16(v0[2], v0[3]); w.z = cvt_pk_bf16(v1[0], v1[1]); w.w = cvt_pk_bf16(v1[2], v1[3]);
                    *(u32x4*)(VT + off) = w; } }
    }
};

struct EpiProj {
    static constexpr bool PERM = true, HAS_MID = false;
    bf16_t *naQ, *naK, *dfQ, *dfK, *Gna, *Gdf; const float *ropeC, *ropeS;
    __device__ __forceinline__ void mid(f32x4 (&)[2][2][4][2], const Unit&, int, int, int, int) const {}
    __device__ __forceinline__ void operator()(const f32x4 (&acc)[2][2][4][2], const Unit& u, int wr, int wc, int fr, int fq) const {
        const int tile = u.pn; const int row0 = u.pm * BM + wr * 64 + fr;
        if (tile >= 8) {
            const int col0 = (tile - 8) * 128 + wc * 32 + 8 * fq;
#pragma unroll
            for (int ai = 0; ai < 2; ++ai)
#pragma unroll
                for (int m = 0; m < 4; ++m) { const size_t off = (size_t)(row0 + ai * HALF + m * 16) * DM + col0;
                    f32x4 rr[2], sd[2];
#pragma unroll
                    for (int n = 0; n < 2; ++n)
#pragma unroll
                        for (int j = 0; j < 4; ++j) { const float ena = __builtin_amdgcn_exp2f(fminf(-acc[ai][0][m][n][j] * LOG2E, 100.f)), edf = __builtin_amdgcn_exp2f(fminf(-acc[ai][1][m][n][j] * LOG2E, 100.f));
                            rr[n][j] = (1.0f + edf) * __builtin_amdgcn_rcpf(1.0f + ena); sd[n][j] = __builtin_amdgcn_rcpf(1.0f + edf); }
                    u32x4 w; w.x = cvt_pk_bf16(rr[0][0], rr[0][1]); w.y = cvt_pk_bf16(rr[0][2], rr[0][3]); w.z = cvt_pk_bf16(rr[1][0], rr[1][1]); w.w = cvt_pk_bf16(rr[1][2], rr[1][3]);
                    __builtin_nontemporal_store(w, (u32x4*)(Gna + off));
                    w.x = cvt_pk_bf16(sd[0][0], sd[0][1]); w.y = cvt_pk_bf16(sd[0][2], sd[0][3]); w.z = cvt_pk_bf16(sd[1][0], sd[1][1]); w.w = cvt_pk_bf16(sd[1][2], sd[1][3]);
                    __builtin_nontemporal_store(w, (u32x4*)(Gdf + off)); }
        } else if (tile < 4) {
            bf16_t* base; int ldc, colt, mode;
            if (tile < 2) { base = naQ; ldc = 512; colt = tile * 256; mode = 1; }
            else { base = naK; ldc = 512; colt = (tile - 2) * 256; mode = 0; }
            const int col0 = colt + wc * 32 + 8 * fq;
#pragma unroll
            for (int ai = 0; ai < 2; ++ai)
#pragma unroll
                for (int m = 0; m < 4; ++m) { bf16_t* rowp = base + (size_t)(row0 + ai * HALF + m * 16) * ldc + col0;
#pragma unroll
                    for (int bj = 0; bj < 2; ++bj) { f32x4 v0 = acc[ai][bj][m][0], v1 = acc[ai][bj][m][1];
                        if (mode == 1) { v0 = v0 * C2; v1 = v1 * C2; }
                        u32x4 w; w.x = cvt_pk_bf16(v0[0], v0[1]); w.y = cvt_pk_bf16(v0[2], v0[3]); w.z = cvt_pk_bf16(v1[0], v1[1]); w.w = cvt_pk_bf16(v1[2], v1[3]);
                        if (mode == 1) __builtin_nontemporal_store(w, (u32x4*)(rowp + bj * HALF)); else *(u32x4*)(rowp + bj * HALF) = w; } }
        } else {
            bf16_t* base = tile < 6 ? dfQ : dfK; const float sc = tile < 6 ? C2 : 1.0f;
            const int cb = ((tile & 1) * 4 + wc) * 64 + 8 * fq;
#pragma unroll
            for (int ai = 0; ai < 2; ++ai)
#pragma unroll
                for (int m = 0; m < 4; ++m) { const int row = row0 + ai * HALF + m * 16; const int pos = NMETA + (row & (SEQ - 1));
                    const f32x4 c0 = *(const f32x4*)(ropeC + pos * 32 + 8 * fq), c1 = *(const f32x4*)(ropeC + pos * 32 + 8 * fq + 4);
                    const f32x4 s0 = *(const f32x4*)(ropeS + pos * 32 + 8 * fq), s1 = *(const f32x4*)(ropeS + pos * 32 + 8 * fq + 4);
                    const f32x4 x10 = acc[ai][0][m][0], x11 = acc[ai][0][m][1], x20 = acc[ai][1][m][0], x21 = acc[ai][1][m][1];
                    const f32x4 a0 = (x10 * c0 - x20 * s0) * sc, a1 = (x11 * c1 - x21 * s1) * sc;
                    const f32x4 b0 = (x20 * c0 + x10 * s0) * sc, b1 = (x21 * c1 + x11 * s1) * sc;
                    bf16_t* rowp = base + (size_t)row * 512 + cb;
                    u32x4 w; w.x = cvt_pk_bf16(a0[0], a0[1]); w.y = cvt_pk_bf16(a0[2], a0[3]); w.z = cvt_pk_bf16(a1[0], a1[1]); w.w = cvt_pk_bf16(a1[2], a1[3]);
                    if (tile < 6) __builtin_nontemporal_store(w, (u32x4*)(rowp)); else *(u32x4*)(rowp) = w;
                    w.x = cvt_pk_bf16(b0[0], b0[1]); w.y = cvt_pk_bf16(b0[2], b0[3]); w.z = cvt_pk_bf16(b1[0], b1[1]); w.w = cvt_pk_bf16(b1[2], b1[3]);
                    if (tile < 6) __builtin_nontemporal_store(w, (u32x4*)(rowp + 32)); else *(u32x4*)(rowp + 32) = w; }
        }
    }
};

struct EpiMerge {
    static constexpr bool PERM = true, HAS_MID = true;
    const bf16_t *Rat, *Sdf; bf16_t* MG;
    __device__ __forceinline__ void mid(f32x4 (&acc)[2][2][4][2], const Unit& u, int wr, int wc, int fr, int fq) const {
        int row0 = u.pm * BM + wr * 64 + fr; const int col0 = u.pn * BM + wc * 32 + 8 * fq;
        asm volatile("" : "+v"(row0));
        const unsigned o = (unsigned)(row0 * DM + col0) * 2u; const char* rb = (const char*)Rat;
#pragma unroll
        for (int ai = 0; ai < 2; ++ai)
#pragma unroll
            for (int m = 0; m < 4; ++m) {
#pragma unroll
                for (int bj = 0; bj < 2; ++bj) { const u32x4 a = __builtin_nontemporal_load((const u32x4*)(rb + (o + (unsigned)(((ai * HALF + m * 16) * DM + bj * HALF) * 2))));
                    acc[ai][bj][m][0][0] *= bf_lo(a.x); acc[ai][bj][m][0][1] *= bf_hi(a.x); acc[ai][bj][m][0][2] *= bf_lo(a.y); acc[ai][bj][m][0][3] *= bf_hi(a.y);
                    acc[ai][bj][m][1][0] *= bf_lo(a.z); acc[ai][bj][m][1][1] *= bf_hi(a.z); acc[ai][bj][m][1][2] *= bf_lo(a.w); acc[ai][bj][m][1][3] *= bf_hi(a.w);
                    asm volatile("" ::: "memory"); } }
    }
    __device__ __forceinline__ void operator()(const f32x4 (&acc)[2][2][4][2], const Unit& u, int wr, int wc, int fr, int fq) const {
        const int row0 = u.pm * BM + wr * 64 + fr, col0 = u.pn * BM + wc * 32 + 8 * fq;
#pragma unroll
        for (int ai = 0; ai < 2; ++ai)
#pragma unroll
            for (int m = 0; m < 4; ++m) { const size_t off = (size_t)(row0 + ai * HALF + m * 16) * DM + col0;
#pragma unroll
                for (int bj = 0; bj < 2; ++bj) { const u32x4 d = __builtin_nontemporal_load((const u32x4*)(Sdf + off + bj * HALF));
                    const f32x4 v0 = acc[ai][bj][m][0], v1 = acc[ai][bj][m][1];
                    u32x4 w; w.x = cvt_pk_bf16(v0[0] * bf_lo(d.x), v0[1] * bf_hi(d.x)); w.y = cvt_pk_bf16(v0[2] * bf_lo(d.y), v0[3] * bf_hi(d.y));
                    w.z = cvt_pk_bf16(v1[0] * bf_lo(d.z), v1[1] * bf_hi(d.z)); w.w = cvt_pk_bf16(v1[2] * bf_lo(d.w), v1[3] * bf_hi(d.w));
                    *(u32x4*)(MG + off + bj * HALF) = w; }
                asm volatile("" ::: "memory"); }
    }
};

struct EpiResid {
    static constexpr bool PERM = false, HAS_MID = false;
    const float* base; float* out;
    __device__ __forceinline__ void mid(f32x4 (&)[2][2][4][2], const Unit&, int, int, int, int) const {}
    __device__ __forceinline__ void operator()(const f32x4 (&acc)[2][2][4][2], const Unit& u, int wr, int wc, int fr, int fq) const {
        const int row0 = u.pm * BM + wr * 64 + fr, col0 = u.pn * BM + wc * 32 + 4 * fq;
#pragma unroll
        for (int ai = 0; ai < 2; ++ai)
#pragma unroll
            for (int m = 0; m < 4; ++m) { const size_t off = (size_t)(row0 + ai * HALF + m * 16) * DM + col0;
#pragma unroll
                for (int bj = 0; bj < 2; ++bj)
#pragma unroll
                    for (int n = 0; n < 2; ++n) { const f32x4 bs = *(const f32x4*)(base + off + bj * HALF + n * 16); *(f32x4*)(out + off + bj * HALF + n * 16) = bs + acc[ai][bj][m][n]; }
                if (m & 1) asm volatile("" ::: "memory"); }
    }
};

struct EpiResidF32toB {
    static constexpr bool PERM = true, HAS_MID = false;
    const float* base; bf16_t* outb;
    __device__ __forceinline__ void mid(f32x4 (&)[2][2][4][2], const Unit&, int, int, int, int) const {}
    __device__ __forceinline__ void operator()(const f32x4 (&acc)[2][2][4][2], const Unit& u, int wr, int wc, int fr, int fq) const {
        const int row0 = u.pm * BM + wr * 64 + fr, col0 = u.pn * BM + wc * 32 + 8 * fq;
#pragma unroll
        for (int ai = 0; ai < 2; ++ai)
#pragma unroll
            for (int m = 0; m < 4; ++m) { const size_t off = (size_t)(row0 + ai * HALF + m * 16) * DM + col0;
#pragma unroll
                for (int bj = 0; bj < 2; ++bj) { const f32x4 b0 = __builtin_nontemporal_load((const f32x4*)(base + off + bj * HALF)), b1 = __builtin_nontemporal_load((const f32x4*)(base + off + bj * HALF + 4));
                    const f32x4 v0 = b0 + acc[ai][bj][m][0], v1 = b1 + acc[ai][bj][m][1];
                    u32x4 w; w.x = cvt_pk_bf16(v0[0], v0[1]); w.y = cvt_pk_bf16(v0[2], v0[3]); w.z = cvt_pk_bf16(v1[0], v1[1]); w.w = cvt_pk_bf16(v1[2], v1[3]);
                    *(u32x4*)(outb + off + bj * HALF) = w; }
                if (m & 1) asm volatile("" ::: "memory"); }
    }
};
struct EpiResidBtoB {
    static constexpr bool PERM = true, HAS_MID = false;
    const bf16_t* baseb; bf16_t* outb;
    __device__ __forceinline__ void mid(f32x4 (&)[2][2][4][2], const Unit&, int, int, int, int) const {}
    __device__ __forceinline__ void operator()(const f32x4 (&acc)[2][2][4][2], const Unit& u, int wr, int wc, int fr, int fq) const {
        const int row0 = u.pm * BM + wr * 64 + fr, col0 = u.pn * BM + wc * 32 + 8 * fq;
#pragma unroll
        for (int ai = 0; ai < 2; ++ai)
#pragma unroll
            for (int m = 0; m < 4; ++m) { const size_t off = (size_t)(row0 + ai * HALF + m * 16) * DM + col0;
#pragma unroll
                for (int bj = 0; bj < 2; ++bj) { const u32x4 b = __builtin_nontemporal_load((const u32x4*)(baseb + off + bj * HALF));
                    const f32x4 a0 = acc[ai][bj][m][0], a1 = acc[ai][bj][m][1];
                    u32x4 w; w.x = cvt_pk_bf16(bf_lo(b.x) + a0[0], bf_hi(b.x) + a0[1]); w.y = cvt_pk_bf16(bf_lo(b.y) + a0[2], bf_hi(b.y) + a0[3]);
                    w.z = cvt_pk_bf16(bf_lo(b.z) + a1[0], bf_hi(b.z) + a1[1]); w.w = cvt_pk_bf16(bf_lo(b.w) + a1[2], bf_hi(b.w) + a1[3]);
                    *(u32x4*)(outb + off + bj * HALF) = w; }
                if (m & 1) asm volatile("" ::: "memory"); }
    }
};

struct EpiSwiGLU {
    static constexpr bool PERM = true, HAS_MID = false;
    bf16_t* ACT; const float* rstdv;
    __device__ __forceinline__ void mid(f32x4 (&)[2][2][4][2], const Unit&, int, int, int, int) const {}
    __device__ __forceinline__ void operator()(const f32x4 (&acc)[2][2][4][2], const Unit& u, int wr, int wc, int fr, int fq) const {
        const int row0 = u.pm * BM + wr * 64 + fr, col0 = u.pn * HALF + wc * 32 + 8 * fq;
#pragma unroll
        for (int ai = 0; ai < 2; ++ai)
#pragma unroll
            for (int m = 0; m < 4; ++m) { const int row = row0 + ai * HALF + m * 16; bf16_t* rowp = ACT + (size_t)row * DFF + col0;
                const float rstd = rstdv[row];
                f32x4 g0 = acc[ai][0][m][0] * rstd, g1 = acc[ai][0][m][1] * rstd; const f32x4 u0 = acc[ai][1][m][0] * rstd, u1 = acc[ai][1][m][1] * rstd;
#pragma unroll
                for (int j = 0; j < 4; ++j) { g0[j] = g0[j] * sigmoidf_fast(g0[j]) * u0[j]; g1[j] = g1[j] * sigmoidf_fast(g1[j]) * u1[j]; }
                u32x4 w; w.x = cvt_pk_bf16(g0[0], g0[1]); w.y = cvt_pk_bf16(g0[2], g0[3]); w.z = cvt_pk_bf16(g1[0], g1[1]); w.w = cvt_pk_bf16(g1[2], g1[3]);
                *(u32x4*)rowp = w; }
    }
};

template <class Epi, class Sched, bool ALIGN_EPI = false, bool SP2 = false>
__device__ __forceinline__ void gemm_phase(LAS unsigned char* lds, const Gemm g, const Sched& S, const Epi& E) {
    const int tid = threadIdx.x, wid = __builtin_amdgcn_readfirstlane(tid >> 6), lane = tid & 63, wr = wid >> 2, wc = wid & 3, fr = lane & 15, fq = lane >> 4;
    const int K = g.K, nt = K / BK;
    unsigned voffA[2], voffB[2];
#pragma unroll
    for (int i = 0; i < 2; ++i) { int R, C; stage_rc(tid * 16 + i * 8192, R, C); const int Rb = Epi::PERM ? ((R & ~31) + perm32(R & 31)) : R;
        voffA[i] = (unsigned)(R * K + C) * 2u; voffB[i] = (unsigned)(Rb * K + C) * 2u; }
    const size_t kstep = (size_t)(BK * 2);
    const size_t hstep = (size_t)HALF * K * 2;
    const size_t tstep = 2 * hstep;
    const unsigned ldsw = (unsigned)wid * 1024u;
    const int aoff = lds_byte(wr * 64 + fr, fq * 8), boff = lds_byte(wc * 32 + fr, fq * 8);
#define PG8_SA(b, h) (((b) * 2 + (h)) * HTB)
#define PG8_SB(b, h) ((4 + (b) * 2 + (h)) * HTB)
#define PG8_STAGE(bufoff, gbase, voff) do { _Pragma("unroll") for (int _i = 0; _i < 2; ++_i) \
        __builtin_amdgcn_global_load_lds((const unsigned*)((const char*)(gbase) + (voff)[_i]), (LAS unsigned*)(lds + (bufoff) + ldsw + _i * 8192), 16, 0, 0); } while (0)
#define PG8_LDA(dst, b, h) do { _Pragma("unroll") for (int m = 0; m < 4; ++m) _Pragma("unroll") for (int k = 0; k < 2; ++k) dst[m][k] = *(const LAS bf16x8*)(lds + PG8_SA(b, h) + aoff + m * 2048 + k * 1024); } while (0)
#define PG8_LDB(dst, b, h) do { _Pragma("unroll") for (int n = 0; n < 2; ++n) _Pragma("unroll") for (int k = 0; k < 2; ++k) dst[n][k] = *(const LAS bf16x8*)(lds + PG8_SB(b, h) + boff + n * 2048 + k * 1024); } while (0)
#define PG8_MMA(ai, bj, At, Bt) do { __builtin_amdgcn_s_setprio(1); _Pragma("unroll") for (int m = 0; m < 4; ++m) _Pragma("unroll") for (int n = 0; n < 2; ++n) _Pragma("unroll") for (int k = 0; k < 2; ++k) \
        acc[ai][bj][m][n] = __builtin_amdgcn_mfma_f32_16x16x32_bf16(Bt[n][k], At[m][k], acc[ai][bj][m][n], 0, 0, 0); __builtin_amdgcn_s_setprio(0); } while (0)
#define PG8_WAIT_V(n) asm volatile("s_waitcnt vmcnt(" #n ")" ::: "memory")
#define PG8_WAIT_L(n) asm volatile("s_waitcnt lgkmcnt(" #n ")" ::: "memory")
#define PG8_BAR __builtin_amdgcn_s_barrier()
#define PG8_SCHED __builtin_amdgcn_sched_barrier(0)
    Unit cur, nxt; int ui = 0;
    if (!S.next(0, cur)) return;
    f32x4 acc[2][2][4][2];
#pragma unroll
    for (int a = 0; a < 2; ++a)
#pragma unroll
        for (int b = 0; b < 2; ++b)
#pragma unroll
            for (int m = 0; m < 4; ++m)
#pragma unroll
                for (int n = 0; n < 2; ++n) acc[a][b][m][n] = (f32x4){0.f, 0.f, 0.f, 0.f};
    bf16x8 At[4][2], B0[2][2], B1[2][2];
    const char* cA = (const char*)g.A + (size_t)cur.pm * tstep; const char* cB = (const char*)g.Bt + (size_t)cur.pn * tstep;
    if constexpr (SP2) {
        PG8_STAGE(PG8_SB(0, 0), cB, voffB); PG8_STAGE(PG8_SB(0, 1), cB + hstep, voffB); PG8_STAGE(PG8_SA(0, 0), cA, voffA); PG8_STAGE(PG8_SA(0, 1), cA + hstep, voffA);
        if (wr == 1) PG8_BAR;
        PG8_WAIT_V(2); PG8_BAR;
        PG8_STAGE(PG8_SB(1, 0), cB + kstep, voffB); PG8_STAGE(PG8_SA(1, 0), cA + kstep, voffA); PG8_STAGE(PG8_SB(1, 1), cB + hstep + kstep, voffB);
        PG8_WAIT_V(6); PG8_BAR;
    } else {
        PG8_STAGE(PG8_SB(0, 0), cB, voffB); PG8_STAGE(PG8_SA(0, 0), cA, voffA); PG8_STAGE(PG8_SB(0, 1), cB + hstep, voffB); PG8_STAGE(PG8_SA(0, 1), cA + hstep, voffA);
        if (wr == 1) PG8_BAR;
        PG8_WAIT_V(4); PG8_BAR;
        PG8_STAGE(PG8_SB(1, 0), cB + kstep, voffB); PG8_STAGE(PG8_SA(1, 0), cA + kstep, voffA); PG8_STAGE(PG8_SB(1, 1), cB + hstep + kstep, voffB);
        PG8_WAIT_V(6); PG8_BAR;
    }
    for (;;) {
        const bool has_next = S.next(ui + 1, nxt);
        const char* nA = has_next ? (const char*)g.A + (size_t)nxt.pm * tstep : cA; const char* nB = has_next ? (const char*)g.Bt + (size_t)nxt.pn * tstep : cB;
        for (int t = 0; t < nt; t += 2) {
            if constexpr (Epi::HAS_MID) { if (t == nt / 2) E.mid(acc, cur, wr, wc, fr, fq); }
            const bool last = (t == nt - 2);
            const char* a1 = cA + (size_t)(t + 1) * kstep;
            const char* a2 = last ? nA : cA + (size_t)(t + 2) * kstep; const char* b2 = last ? nB : cB + (size_t)(t + 2) * kstep;
            const char* a3 = a2 + kstep; const char* b3 = b2 + kstep;
            if constexpr (SP2) {
            PG8_LDB(B0, 0, 0); PG8_LDB(B1, 0, 1); PG8_SCHED; PG8_LDA(At, 0, 0); PG8_STAGE(PG8_SA(1, 1), a1 + hstep, voffA);
            PG8_WAIT_V(8); PG8_WAIT_L(0); PG8_BAR; PG8_MMA(0, 0, At, B0); PG8_MMA(0, 1, At, B1); PG8_BAR; PG8_SCHED;
            PG8_LDA(At, 0, 1); PG8_STAGE(PG8_SB(0, 0), b2, voffB); PG8_STAGE(PG8_SB(0, 1), b2 + hstep, voffB); PG8_STAGE(PG8_SA(0, 0), a2, voffA);
            PG8_WAIT_V(8); PG8_WAIT_L(0); PG8_BAR; PG8_MMA(1, 0, At, B0); PG8_MMA(1, 1, At, B1); PG8_BAR; PG8_SCHED;
            PG8_LDB(B0, 1, 0); PG8_LDB(B1, 1, 1); PG8_SCHED; PG8_LDA(At, 1, 0); PG8_STAGE(PG8_SA(0, 1), a2 + hstep, voffA);
            PG8_WAIT_V(8); PG8_WAIT_L(0); PG8_BAR; PG8_MMA(0, 0, At, B0); PG8_MMA(0, 1, At, B1); PG8_BAR; PG8_SCHED;
            PG8_LDA(At, 1, 1); PG8_STAGE(PG8_SB(1, 0), b3, voffB); PG8_STAGE(PG8_SB(1, 1), b3 + hstep, voffB); PG8_STAGE(PG8_SA(1, 0), a3, voffA);
            PG8_WAIT_V(8); PG8_WAIT_L(0); PG8_BAR; PG8_MMA(1, 0, At, B0); PG8_MMA(1, 1, At, B1); PG8_BAR; PG8_SCHED;
            } else {
            PG8_LDB(B0, 0, 0); PG8_SCHED; PG8_LDA(At, 0, 0); PG8_STAGE(PG8_SA(1, 1), a1 + hstep, voffA);
            PG8_WAIT_L(8); PG8_BAR; PG8_WAIT_L(0); PG8_MMA(0, 0, At, B0); PG8_BAR; PG8_SCHED;
            PG8_LDB(B1, 0, 1); PG8_STAGE(PG8_SB(0, 0), b2, voffB);
            PG8_BAR; PG8_WAIT_L(0); PG8_MMA(0, 1, At, B1); PG8_BAR;
            PG8_LDA(At, 0, 1); PG8_STAGE(PG8_SA(0, 0), a2, voffA);
            PG8_BAR; PG8_WAIT_L(0); PG8_MMA(1, 0, At, B0); PG8_BAR; PG8_SCHED;
            PG8_STAGE(PG8_SB(0, 1), b2 + hstep, voffB);
            PG8_WAIT_V(6); PG8_BAR; PG8_MMA(1, 1, At, B1); PG8_BAR;
            PG8_LDB(B0, 1, 0); PG8_SCHED; PG8_LDA(At, 1, 0); PG8_STAGE(PG8_SA(0, 1), a2 + hstep, voffA);
            PG8_WAIT_L(8); PG8_BAR; PG8_WAIT_L(0); PG8_MMA(0, 0, At, B0); PG8_BAR; PG8_SCHED;
            PG8_LDB(B1, 1, 1); PG8_STAGE(PG8_SB(1, 0), b3, voffB);
            PG8_BAR; PG8_WAIT_L(0); PG8_MMA(0, 1, At, B1); PG8_BAR;
            PG8_LDA(At, 1, 1); PG8_STAGE(PG8_SA(1, 0), a3, voffA);
            PG8_BAR; PG8_WAIT_L(0); PG8_MMA(1, 0, At, B0); PG8_BAR; PG8_SCHED;
            PG8_STAGE(PG8_SB(1, 1), b3 + hstep, voffB);
            PG8_WAIT_V(6); PG8_BAR; PG8_MMA(1, 1, At, B1); PG8_BAR;
            }
        }
        if constexpr (ALIGN_EPI) { if (wr == 0) PG8_BAR; }
        E(acc, cur, wr, wc, fr, fq);
        if (!has_next) break;
#pragma unroll
        for (int a = 0; a < 2; ++a)
#pragma unroll
            for (int b = 0; b < 2; ++b)
#pragma unroll
                for (int m = 0; m < 4; ++m)
#pragma unroll
                    for (int n = 0; n < 2; ++n) acc[a][b][m][n] = (f32x4){0.f, 0.f, 0.f, 0.f};
        cur = nxt; cA = nA; cB = nB; ++ui;
        if constexpr (ALIGN_EPI) { if (wr == 1) PG8_BAR; }
    }
    PG8_WAIT_V(0);
    if constexpr (!ALIGN_EPI) { if (wr == 0) PG8_BAR; }
    PG8_BAR;
#undef PG8_SA
#undef PG8_SB
#undef PG8_STAGE
#undef PG8_LDA
#undef PG8_LDB
#undef PG8_MMA
#undef PG8_WAIT_V
#undef PG8_WAIT_L
#undef PG8_BAR
#undef PG8_SCHED
}
}
using pg8::cvt_pk_bf16;

constexpr int NWAVES = 8, NTHR = 512;
constexpr int LDS_BYTES = 147456;

struct Args { const float* in[18]; float* out; unsigned char* ws; int ph_lo, ph_hi; };

#define MFMA32(a, b, c) __builtin_amdgcn_mfma_f32_32x32x16_bf16((a), (b), (c), 0, 0, 0)
__device__ __forceinline__ float wave_sum(float v) {
#pragma unroll
    for (int o = 1; o < 64; o <<= 1) v += __shfl_xor(v, o);
    return v;
}
__device__ __forceinline__ int crow(int i, int h) { return (i & 3) + 8 * (i >> 2) + 4 * h; }
__device__ __forceinline__ int kperm(int r) { return (r & 19) | ((r & 4) << 1) | ((r & 8) >> 1); }

__device__ __forceinline__ void rope_cs(int pos, int i, float& c, float& s) {
    const float inv = exp2f(-(float)i * (13.287712379549449f / 32.0f));
    const float ang = (float)pos * inv;
    double rev = (double)ang * 0.15915494309189535; rev -= floor(rev);
    const float rf = (float)rev;
    c = __builtin_amdgcn_cosf(rf); s = __builtin_amdgcn_sinf(rf);
}

__device__ __forceinline__ void transpose_block(const float* W, int ldw, int srck0, int srccol0, bf16_t* WT, int ldt, int dstrow0, int dstk0, LAS float* scr, int lane, const float* kscale, float kmul, int kmask = 127) {
#pragma unroll 8
    for (int i = 0; i < 32; ++i) { const int kk = 2 * i + (lane >> 5); float v = __builtin_nontemporal_load(W + (size_t)(srck0 + kk) * ldw + srccol0 + (lane & 31));
        if (kscale) v *= kscale[(srck0 + kk) & kmask] * kmul;
        scr[kk * 33 + (lane & 31)] = v; }
    asm volatile("s_waitcnt lgkmcnt(0)" ::: "memory");
    const int c = lane & 7;
#pragma unroll
    for (int j = 0; j < 4; ++j) { const int n = (lane >> 3) + 8 * j; const LAS float* s = scr + (8 * c) * 33 + n;
        u32x4 o; o.x = cvt_pk_bf16(s[0 * 33], s[1 * 33]); o.y = cvt_pk_bf16(s[2 * 33], s[3 * 33]); o.z = cvt_pk_bf16(s[4 * 33], s[5 * 33]); o.w = cvt_pk_bf16(s[6 * 33], s[7 * 33]);
        *(u32x4*)(WT + (size_t)(dstrow0 + n) * ldt + dstk0 + 8 * c) = o; }
    asm volatile("s_waitcnt lgkmcnt(0)" ::: "memory");
}

__device__ __forceinline__ void rms_row_bf16(const float* xrow, const f32x4 (&g)[4], bf16_t* orow, int lane, float eps) {
    const f32x4* xr = (const f32x4*)xrow + lane;
    f32x4 v[4]; float s = 0.f;
#pragma unroll
    for (int j = 0; j < 4; ++j) { v[j] = __builtin_nontemporal_load(xr + 64 * j); s += (v[j].x * v[j].x + v[j].y * v[j].y) + (v[j].z * v[j].z + v[j].w * v[j].w); }
    const float rstd = 1.0f / sqrtf(wave_sum(s) * (1.0f / DM) + eps);
    u32x2* o8 = (u32x2*)orow + lane;
#pragma unroll
    for (int j = 0; j < 4; ++j) { u32x2 w; w.x = cvt_pk_bf16(v[j].x * rstd * g[j].x, v[j].y * rstd * g[j].y); w.y = cvt_pk_bf16(v[j].z * rstd * g[j].z, v[j].w * rstd * g[j].w); o8[64 * j] = w; }
}

__device__ __forceinline__ void rms_rowb_bf16(const bf16_t* xrow, const float* g, bf16_t* orow, int lane, float eps) {
    const u32x4 a = *((const u32x4*)xrow + lane), b = *((const u32x4*)xrow + 64 + lane);
    float v[16]; v[0] = pg8::bf_lo(a.x); v[1] = pg8::bf_hi(a.x); v[2] = pg8::bf_lo(a.y); v[3] = pg8::bf_hi(a.y); v[4] = pg8::bf_lo(a.z); v[5] = pg8::bf_hi(a.z); v[6] = pg8::bf_lo(a.w); v[7] = pg8::bf_hi(a.w);
    v[8] = pg8::bf_lo(b.x); v[9] = pg8::bf_hi(b.x); v[10] = pg8::bf_lo(b.y); v[11] = pg8::bf_hi(b.y); v[12] = pg8::bf_lo(b.z); v[13] = pg8::bf_hi(b.z); v[14] = pg8::bf_lo(b.w); v[15] = pg8::bf_hi(b.w);
    float s = 0.f;
#pragma unroll
    for (int j = 0; j < 16; ++j) s += v[j] * v[j];
    const float rstd = 1.0f / sqrtf(wave_sum(s) * (1.0f / DM) + eps);
    const f32x4 g0 = *(const f32x4*)(g + 8 * lane), g1 = *(const f32x4*)(g + 8 * lane + 4), g2 = *(const f32x4*)(g + 512 + 8 * lane), g3 = *(const f32x4*)(g + 512 + 8 * lane + 4);
    u32x4 o; o.x = cvt_pk_bf16(v[0] * rstd * g0[0], v[1] * rstd * g0[1]); o.y = cvt_pk_bf16(v[2] * rstd * g0[2], v[3] * rstd * g0[3]); o.z = cvt_pk_bf16(v[4] * rstd * g1[0], v[5] * rstd * g1[1]); o.w = cvt_pk_bf16(v[6] * rstd * g1[2], v[7] * rstd * g1[3]);
    *((u32x4*)orow + lane) = o;
    o.x = cvt_pk_bf16(v[8] * rstd * g2[0], v[9] * rstd * g2[1]); o.y = cvt_pk_bf16(v[10] * rstd * g2[2], v[11] * rstd * g2[3]); o.z = cvt_pk_bf16(v[12] * rstd * g3[0], v[13] * rstd * g3[1]); o.w = cvt_pk_bf16(v[14] * rstd * g3[2], v[15] * rstd * g3[3]);
    *((u32x4*)orow + 64 + lane) = o;
}
__device__ __forceinline__ void rms_rowb_f32(const bf16_t* xrow, const float* g, float* orow, int lane, float eps) {
    const u32x4 a = __builtin_nontemporal_load((const u32x4*)xrow + lane), b = __builtin_nontemporal_load((const u32x4*)xrow + 64 + lane);
    float v[16]; v[0] = pg8::bf_lo(a.x); v[1] = pg8::bf_hi(a.x); v[2] = pg8::bf_lo(a.y); v[3] = pg8::bf_hi(a.y); v[4] = pg8::bf_lo(a.z); v[5] = pg8::bf_hi(a.z); v[6] = pg8::bf_lo(a.w); v[7] = pg8::bf_hi(a.w);
    v[8] = pg8::bf_lo(b.x); v[9] = pg8::bf_hi(b.x); v[10] = pg8::bf_lo(b.y); v[11] = pg8::bf_hi(b.y); v[12] = pg8::bf_lo(b.z); v[13] = pg8::bf_hi(b.z); v[14] = pg8::bf_lo(b.w); v[15] = pg8::bf_hi(b.w);
    float s = 0.f;
#pragma unroll
    for (int j = 0; j < 16; ++j) s += v[j] * v[j];
    const float rstd = 1.0f / sqrtf(wave_sum(s) * (1.0f / DM) + eps);
    const f32x4 g0 = *(const f32x4*)(g + 8 * lane), g1 = *(const f32x4*)(g + 8 * lane + 4), g2 = *(const f32x4*)(g + 512 + 8 * lane), g3 = *(const f32x4*)(g + 512 + 8 * lane + 4);
    f32x4* o = (f32x4*)orow;
    __builtin_nontemporal_store((f32x4){v[0], v[1], v[2], v[3]} * rstd * g0, o + 2 * lane); __builtin_nontemporal_store((f32x4){v[4], v[5], v[6], v[7]} * rstd * g1, o + 2 * lane + 1);
    __builtin_nontemporal_store((f32x4){v[8], v[9], v[10], v[11]} * rstd * g2, o + 128 + 2 * lane); __builtin_nontemporal_store((f32x4){v[12], v[13], v[14], v[15]} * rstd * g3, o + 128 + 2 * lane + 1);
}

#define CFENCE() do { asm volatile("" ::: "memory"); __builtin_amdgcn_sched_barrier(0); } while (0)
__device__ __forceinline__ float xhalf_max(float m) {
    auto rr = __builtin_amdgcn_permlane32_swap(__float_as_uint(m), __float_as_uint(m), false, false);
    return fmaxf(__uint_as_float(rr[0]), __uint_as_float(rr[1]));
}
template <bool META, int KB>
__device__ __forceinline__ void da_substep(const LAS unsigned char* kbuf, const LAS unsigned char* vbuf, const int k0x, const int vt, const bf16x8 (&qf0)[4], const LAS unsigned char* q1p,
                                           f32x16 (&O)[2][4], float (&mrun)[2], float (&lrun)[2]) {
#define DA_VF(e, s) (*(const LAS bf16x8*)(vbuf + (e) * 4096 + ((((4 * KB + (s) * 2)) << 4) ^ vt)))
    bf16x8 pf[2][2];
    bf16x8 va0, va1, vb0, vb1;
#pragma unroll
    for (int c = 0; c < 2; ++c) {
        f32x16 x;
        {
            bf16x8 kf[4], q1[4];
#pragma unroll
            for (int ks = 0; ks < 4; ++ks) kf[ks] = *(const LAS bf16x8*)(kbuf + c * 8192 + (k0x ^ (ks * 32)));
            if (c == 1) {
#pragma unroll
                for (int ks = 0; ks < 4; ++ks) q1[ks] = *(const LAS bf16x8*)(q1p + ks * 1024);
            }
            CFENCE();
#pragma unroll
            for (int i = 0; i < 16; ++i) x[i] = 0.f;
#pragma unroll
            for (int ks = 0; ks < 4; ++ks) x = MFMA32(kf[ks], c == 0 ? qf0[ks] : q1[ks], x);
        }
        CFENCE();
        if (c == 1) { va0 = DA_VF(0, 0); va1 = DA_VF(0, 1); vb0 = DA_VF(1, 0); vb1 = DA_VF(1, 1); CFENCE(); }
        if (META) {
#pragma unroll
            for (int i = 8; i < 16; ++i) x[i] = -INFINITY;
        }
        float ra = fmaxf(fmaxf(x[0], x[1]), x[2]), rb = fmaxf(fmaxf(x[3], x[4]), x[5]);
        ra = fmaxf(fmaxf(ra, x[6]), x[7]); rb = fmaxf(fmaxf(rb, x[8]), x[9]); ra = fmaxf(fmaxf(ra, x[10]), x[11]); rb = fmaxf(fmaxf(rb, x[12]), x[13]); ra = fmaxf(fmaxf(ra, x[14]), x[15]);
        const float lmx = fmaxf(ra, rb);
        if (__any(lmx > mrun[c])) {
            const float rm = xhalf_max(lmx);
            const float mn = fmaxf(mrun[c], rm + 8.0f); const float al = __builtin_amdgcn_exp2f(mrun[c] - mn); mrun[c] = mn; lrun[c] *= al;
#pragma unroll
            for (int e = 0; e < 4; ++e)
#pragma unroll
                for (int i = 0; i < 16; ++i) O[c][e][i] *= al;
        }
        const float mm = mrun[c]; float sa = 0.f, sb = 0.f;
#pragma unroll
        for (int i = 0; i < 16; i += 2) { x[i] = __builtin_amdgcn_exp2f(x[i] - mm); x[i + 1] = __builtin_amdgcn_exp2f(x[i + 1] - mm); sa += x[i]; sb += x[i + 1]; }
        lrun[c] += sa + sb;
#pragma unroll
        for (int s = 0; s < 2; ++s) { u32x4 p; p.x = cvt_pk_bf16(x[8 * s], x[8 * s + 1]); p.y = cvt_pk_bf16(x[8 * s + 2], x[8 * s + 3]); p.z = cvt_pk_bf16(x[8 * s + 4], x[8 * s + 5]); p.w = cvt_pk_bf16(x[8 * s + 6], x[8 * s + 7]);
            pf[c][s] = __builtin_bit_cast(bf16x8, p); }
        CFENCE();
    }
    O[0][0] = MFMA32(va0, pf[0][0], O[0][0]); O[1][0] = MFMA32(va0, pf[1][0], O[1][0]); O[0][0] = MFMA32(va1, pf[0][1], O[0][0]); O[1][0] = MFMA32(va1, pf[1][1], O[1][0]);
    va0 = DA_VF(2, 0); va1 = DA_VF(2, 1);
    CFENCE();
    O[0][1] = MFMA32(vb0, pf[0][0], O[0][1]); O[1][1] = MFMA32(vb0, pf[1][0], O[1][1]); O[0][1] = MFMA32(vb1, pf[0][1], O[0][1]); O[1][1] = MFMA32(vb1, pf[1][1], O[1][1]);
    vb0 = DA_VF(3, 0); vb1 = DA_VF(3, 1);
    CFENCE();
    O[0][2] = MFMA32(va0, pf[0][0], O[0][2]); O[1][2] = MFMA32(va0, pf[1][0], O[1][2]); O[0][2] = MFMA32(va1, pf[0][1], O[0][2]); O[1][2] = MFMA32(va1, pf[1][1], O[1][2]);
    O[0][3] = MFMA32(vb0, pf[0][0], O[0][3]); O[1][3] = MFMA32(vb0, pf[1][0], O[1][3]); O[0][3] = MFMA32(vb1, pf[0][1], O[0][3]); O[1][3] = MFMA32(vb1, pf[1][1], O[1][3]);
    CFENCE();
#undef DA_VF
}

__device__ __forceinline__ void diff_unit(int b, int h, int qb, const bf16_t* dfQ, const bf16_t* dfK, const bf16_t* VT, const bf16_t* dfKm, const bf16_t* dfVTm,
                                          bf16_t* AO, float lam, LAS unsigned char* lds, int wid, int lane) {
    const int r = lane & 31, hl = lane >> 5;
    const size_t qrow = (size_t)b * SEQ + qb * 256 + wid * 32 + r;
    const int dkey = 8 * wid + (lane >> 3); const int dsc = (lane & 7) ^ ((dkey >> 1) & 7);
    const unsigned kof = (unsigned)(dkey * 512 + (2 * h) * 64 + dsc * 8);
    const int de0 = 8 * wid + (lane >> 3), de1 = de0 + 64;
    const int vsc0 = (lane & 7) ^ ((de0 >> 1) & 7), vsc1 = (lane & 7) ^ ((de1 >> 1) & 7);
    const unsigned vof0_m = (unsigned)((h * 128 + de0) * 64 + vsc0 * 8), vof1_m = (unsigned)((h * 128 + de1) * 64 + vsc1 * 8);
    const unsigned vof0 = (unsigned)(de0 * 64 + vsc0 * 8), vof1 = (unsigned)(de1 * 64 + vsc1 * 8);
    const bf16_t* kbase_r = dfK + (size_t)b * SEQ * 512;
    const bf16_t* vbase_r = VT + (size_t)16777216 + (size_t)((b * 4 + h) * 128) * 8192;
#define DA_DMA(src, dstoff) __builtin_amdgcn_global_load_lds((const unsigned*)(src), (LAS unsigned*)(lds + (dstoff)), 16, 0, 0)
#define DA_ISSUE(t) do { const int bo_ = ((t) & 1) * 32768 + wid * 1024; \
        if ((t) == 0) { DA_DMA(dfKm + kof, bo_); DA_DMA(dfKm + kof + 64, bo_ + 8192); DA_DMA(dfVTm + vof0_m, bo_ + 16384); DA_DMA(dfVTm + vof1_m, bo_ + 16384 + 8192); } \
        else { const bf16_t* kb_ = kbase_r + (size_t)((t) - 1) * 64 * 512; const bf16_t* vb_ = vbase_r + (size_t)((t) - 1) * 8192; \
               DA_DMA(kb_ + kof, bo_); DA_DMA(kb_ + kof + 64, bo_ + 8192); DA_DMA(vb_ + vof0, bo_ + 16384); DA_DMA(vb_ + vof1, bo_ + 16384 + 8192); } } while (0)
    DA_ISSUE(0);
    bf16x8 qf0[4];
    LAS unsigned char* q1p = lds + 65536 + wid * 4096 + lane * 16;
#pragma unroll
    for (int ks = 0; ks < 4; ++ks) { qf0[ks] = __builtin_nontemporal_load((const bf16x8*)(dfQ + qrow * 512 + (2 * h) * 64 + ks * 16 + hl * 8));
        *(LAS bf16x8*)(q1p + ks * 1024) = __builtin_nontemporal_load((const bf16x8*)(dfQ + qrow * 512 + (2 * h + 1) * 64 + ks * 16 + hl * 8)); }
    const int pk = kperm(r); const int kswz = (pk >> 1) & 7;
    const int k0x = pk * 128 + ((hl ^ kswz) << 4);
    const int vbase = 16384 + r * 128; const int vt = (hl ^ ((r >> 1) & 7)) << 4;
    f32x16 O[2][4];
#pragma unroll
    for (int c = 0; c < 2; ++c)
#pragma unroll
        for (int e = 0; e < 4; ++e)
#pragma unroll
            for (int i = 0; i < 16; ++i) O[c][e][i] = 0.f;
    float mrun[2] = {-1e30f, -1e30f}, lrun[2] = {0.f, 0.f};
    constexpr int NT = 1 + SEQ / 64;
    asm volatile("s_waitcnt vmcnt(0)" ::: "memory");
    __syncthreads();
    DA_ISSUE(1);
    da_substep<true, 0>(lds, lds + vbase, k0x, vt, qf0, q1p, O, mrun, lrun);
    for (int t = 1; t < NT; ++t) {
        asm volatile("s_waitcnt vmcnt(0)" ::: "memory");
        __syncthreads();
        if (t + 1 < NT) DA_ISSUE(t + 1);
        const LAS unsigned char* buf = lds + (t & 1) * 32768;
        da_substep<false, 0>(buf, buf + vbase, k0x, vt, qf0, q1p, O, mrun, lrun);
        da_substep<false, 1>(buf + 4096, buf + vbase, k0x, vt, qf0, q1p, O, mrun, lrun);
    }
    float l0 = lrun[0] + __shfl_xor(lrun[0], 32), l1 = lrun[1] + __shfl_xor(lrun[1], 32);
    const float i0 = 1.0f / l0, i1 = lam / l1;
    float ss = 0.f;
#pragma unroll
    for (int e = 0; e < 4; ++e)
#pragma unroll
        for (int i = 0; i < 16; ++i) { const float o = O[0][e][i] * i0 - O[1][e][i] * i1; O[0][e][i] = o; ss += o * o; }
    ss += __shfl_xor(ss, 32);
    const float rs = 1.0f / sqrtf(ss * (1.0f / 128.0f) + 1e-5f);
    { LAS unsigned char* ost = lds + 98304 + wid * 5120;
      bf16_t* obase = AO + ((size_t)b * SEQ + qb * 256 + wid * 32) * DM + 512 + h * 128;
#pragma unroll
      for (int hf = 0; hf < 2; ++hf) {
#pragma unroll
          for (int e2 = 0; e2 < 2; ++e2)
#pragma unroll
              for (int g = 0; g < 4; ++g) { const int e = 2 * hf + e2; u32x2 w; w.x = cvt_pk_bf16(O[0][e][4 * g] * rs, O[0][e][4 * g + 1] * rs); w.y = cvt_pk_bf16(O[0][e][4 * g + 2] * rs, O[0][e][4 * g + 3] * rs);
                  *(LAS u32x2*)(ost + r * 144 + (32 * e2 + 8 * g + 4 * hl) * 2) = w; }
#pragma unroll
          for (int it = 0; it < 4; ++it) { const int row = 8 * it + (lane >> 3), ch = lane & 7;
              const u32x4 v = *(const LAS u32x4*)(ost + row * 144 + ch * 16);
              *(u32x4*)(obase + (size_t)row * DM + 64 * hf + ch * 8) = v; }
      } }
    __syncthreads();
#undef DA_DMA
#undef DA_ISSUE
}

constexpr int NA_RPB_PAD = 128;
__device__ __forceinline__ void na_softmax_pv(f32x16& x, const bf16x8 (&vf)[2][2], bool meta, f32x16 (&O)[2], float& mrun, float& lrun) {
    float ra = fmaxf(fmaxf(x[0], x[1]), x[2]), rb = fmaxf(fmaxf(x[3], x[4]), x[5]);
    ra = fmaxf(fmaxf(ra, x[6]), x[7]); rb = fmaxf(fmaxf(rb, x[8]), x[9]); ra = fmaxf(fmaxf(ra, x[10]), x[11]); rb = fmaxf(fmaxf(rb, x[12]), x[13]); ra = fmaxf(fmaxf(ra, x[14]), x[15]);
    const float lmx = fmaxf(ra, rb);
    if (__any(lmx > mrun)) {
        const float rm = xhalf_max(lmx);
        const float mn = fmaxf(mrun, rm + 8.0f); const float al = __builtin_amdgcn_exp2f(mrun - mn); mrun = mn; lrun *= al;
#pragma unroll
        for (int e = 0; e < 2; ++e)
#pragma unroll
            for (int i = 0; i < 16; ++i) O[e][i] *= al;
    }
    const float mm = mrun; float sa = 0.f, sb = 0.f;
#pragma unroll
    for (int i = 0; i < 16; i += 2) { x[i] = __builtin_amdgcn_exp2f(x[i] - mm); x[i + 1] = __builtin_amdgcn_exp2f(x[i + 1] - mm); sa += x[i]; sb += x[i + 1]; }
    lrun += sa + sb;
    bf16x8 pf[2];
#pragma unroll
    for (int s = 0; s < 2; ++s) { u32x4 p; p.x = cvt_pk_bf16(x[8 * s], x[8 * s + 1]); p.y = cvt_pk_bf16(x[8 * s + 2], x[8 * s + 3]); p.z = cvt_pk_bf16(x[8 * s + 4], x[8 * s + 5]); p.w = cvt_pk_bf16(x[8 * s + 6], x[8 * s + 7]);
        pf[s] = __builtin_bit_cast(bf16x8, p); }
#pragma unroll
    for (int e = 0; e < 2; ++e) { O[e] = MFMA32(vf[e][0], pf[0], O[e]); if (!meta) O[e] = MFMA32(vf[e][1], pf[1], O[e]); }
}

__device__ __forceinline__ void na_unit(int b, int h, int gr, int half, const bf16_t* naQ, const bf16_t* naK, const bf16_t* VT, const bf16_t* naKm, const bf16_t* naVTm,
                                        bf16_t* AO, const LAS float* rpbL, LAS unsigned char* kst, int lane) {
    const int r = lane & 31, hl = lane >> 5;
    const int w = 32 * half + r; const size_t qrow = (size_t)b * SEQ + gr * 64 + w;
    bf16x8 qf[4];
#pragma unroll
    for (int ks = 0; ks < 4; ++ks) qf[ks] = __builtin_nontemporal_load((const bf16x8*)(naQ + qrow * 512 + h * 64 + ks * 16 + hl * 8));
    const int rs = min(max(gr - 4, 0), 120), c0 = 16 * half, cs = min(max(w - 8, 0), 48);
    const int pk = kperm(r);
    float madd[3][8]; int bofs[3]; int koff[3];
#pragma unroll
    for (int g = 0; g < 3; ++g) { const int cb = c0 + 16 * g + 8 * hl;
#pragma unroll
        for (int j = 0; j < 8; ++j) madd[g][j] = ((unsigned)(cb + j - cs) < 16u) ? 0.f : -INFINITY;
        bofs[g] = (NA_RPB_PAD + h * 465 + cb - w + 15) * 4; }
    int kdo[3][4];
#pragma unroll
    for (int t = 0; t < 3; ++t)
#pragma unroll
        for (int i = 0; i < 4; ++i) { const int rho = 8 * i + (lane >> 3); const int v = 32 * t + kperm(rho); const int q = v >= 48 ? 1 : 0;
            kdo[t][i] = (q * 64 + (v - 48 * q)) * 512 + (((lane & 7) ^ ((rho >> 1) & 7)) << 3); }
    (void)koff; (void)pk;
    const int k0x = r * 128 + ((hl ^ ((r >> 1) & 7)) << 4);
    f32x16 O[2];
#pragma unroll
    for (int e = 0; e < 2; ++e)
#pragma unroll
        for (int i = 0; i < 16; ++i) O[e][i] = 0.f;
    float mrun = -1e30f, lrun = 0.f;
    const LAS unsigned char* rpbB = (const LAS unsigned char*)rpbL;
    const bf16_t* kbase0 = naK + ((size_t)b * SEQ + (size_t)rs * 64 + c0) * 512 + h * 64;
#define NA_KDMA(KK, T, BUF) do { _Pragma("unroll") for (int i_ = 0; i_ < 4; ++i_) \
        __builtin_amdgcn_global_load_lds((const unsigned*)(kbase0 + (size_t)(2 * (KK)) * 64 * 512 + kdo[T][i_]), (LAS unsigned*)(kst + (BUF) * 4096 + i_ * 1024), 16, 0, 0); } while (0)
    const bf16_t* vbase = VT + (size_t)((b * 8 + h) * 128 + rs) * 4096 + half * 1024 + r * 16 + 8 * hl;
    const int browb = (rs - gr + 7) * 31 * 4;
#define NA_GROUP(X, S, G, ROW) do { const LAS unsigned char* bp_ = rpbB + (browb + (ROW) * 124 + bofs[G]); \
        _Pragma("unroll") for (int j_ = 0; j_ < 8; ++j_) X[8 * (S) + j_] = (X[8 * (S) + j_] + *(const LAS float*)(bp_ + 4 * j_)) + madd[G][j_]; } while (0)
#define NA_BLOCK(T, G0, R0, G1, R1, BUF, LAST) do { \
        f32x16 x_; _Pragma("unroll") for (int i_ = 0; i_ < 16; ++i_) x_[i_] = 0.f; \
        bf16x8 vf_[2][2]; \
        _Pragma("unroll") for (int e_ = 0; e_ < 2; ++e_) { vf_[e_][0] = *(const bf16x8*)(vbase + (2 * kk + (R0)) * 4096 + 1024 * (G0) + e_ * 512); vf_[e_][1] = *(const bf16x8*)(vbase + (2 * kk + (R1)) * 4096 + 1024 * (G1) + e_ * 512); } \
        if ((T) < 2) { NA_KDMA(kk, (T) + 1, 1 - (BUF)); asm volatile("s_waitcnt vmcnt(8)" ::: "memory"); } \
        else if (!(LAST)) { NA_KDMA(kk + 1, 0, 1 - (BUF)); asm volatile("s_waitcnt vmcnt(8)" ::: "memory"); } \
        else { asm volatile("s_waitcnt vmcnt(4)" ::: "memory"); } \
        bf16x8 kf_[4]; _Pragma("unroll") for (int ks_ = 0; ks_ < 4; ++ks_) kf_[ks_] = *(const LAS bf16x8*)(kst + (BUF) * 4096 + (k0x ^ (ks_ * 32))); \
        _Pragma("unroll") for (int ks_ = 0; ks_ < 4; ++ks_) x_ = MFMA32(kf_[ks_], qf[ks_], x_); \
        NA_GROUP(x_, 0, G0, 2 * kk + (R0)); NA_GROUP(x_, 1, G1, 2 * kk + (R1)); \
        na_softmax_pv(x_, vf_, false, O, mrun, lrun); } while (0)
    NA_KDMA(0, 0, 0);
    for (int kk = 0; kk < 4; kk += 2) {
        NA_BLOCK(0, 0, 0, 1, 0, 0, false);
        NA_BLOCK(1, 2, 0, 0, 1, 1, false);
        NA_BLOCK(2, 1, 1, 2, 1, 0, false);
        ++kk;
        NA_BLOCK(0, 0, 0, 1, 0, 1, false);
        NA_BLOCK(1, 2, 0, 0, 1, 0, false);
        NA_BLOCK(2, 1, 1, 2, 1, 1, kk == 3);
        --kk;
    }
#undef NA_BLOCK
#undef NA_GROUP
#undef NA_KDMA
    { f32x16 x;
#pragma unroll
      for (int i = 0; i < 16; ++i) x[i] = 0.f;
      bf16x8 vfm[2][2];
#pragma unroll
      for (int e = 0; e < 2; ++e) { vfm[e][0] = *(const bf16x8*)(naVTm + (size_t)(h * 64 + 32 * e + r) * 32 + 8 * hl); vfm[e][1] = vfm[e][0]; }
#pragma unroll
      for (int ks = 0; ks < 4; ++ks) { const bf16x8 kf = *(const bf16x8*)(naKm + (size_t)pk * 512 + h * 64 + hl * 8 + ks * 16); x = MFMA32(kf, qf[ks], x); }
#pragma unroll
      for (int i = 8; i < 16; ++i) x[i] = -INFINITY;
      na_softmax_pv(x, vfm, true, O, mrun, lrun); }
    const float l = lrun + __shfl_xor(lrun, 32); const float il = 1.0f / l;
    { bf16_t* obase = AO + ((size_t)b * SEQ + gr * 64 + 32 * half) * DM + h * 64;
#pragma unroll
      for (int e = 0; e < 2; ++e)
#pragma unroll
          for (int g = 0; g < 4; ++g) { u32x2 wv; wv.x = cvt_pk_bf16(O[e][4 * g] * il, O[e][4 * g + 1] * il); wv.y = cvt_pk_bf16(O[e][4 * g + 2] * il, O[e][4 * g + 3] * il);
              *(LAS u32x2*)(kst + r * 144 + (32 * e + 8 * g + 4 * hl) * 2) = wv; }
#pragma unroll
      for (int it = 0; it < 4; ++it) { const int row = 8 * it + (lane >> 3), ch = lane & 7;
          const u32x4 v = *(const LAS u32x4*)(kst + row * 144 + ch * 16);
          *(u32x4*)(obase + (size_t)row * DM + ch * 8) = v; }
      asm volatile("s_waitcnt lgkmcnt(0)" ::: "memory"); }
}

#define XB_TMO      128
#define XB_XCNT(j)  (256  + 64 * (j))
#define XB_XSUB(j)  (1280 + 64 * (j))
#define XB_XGEN(j)  (2304 + 64 * (j))
#define XB_TOP      3328
#define XB_TOPGEN   3392
#define XCD_BAR_WORDS 3456
#define XB_SPIN_CAP (1u << 18)
__device__ __forceinline__ unsigned xb_ld(unsigned* p)              { return __hip_atomic_load(p, __ATOMIC_RELAXED, __HIP_MEMORY_SCOPE_AGENT); }
__device__ __forceinline__ unsigned xb_add(unsigned* p, unsigned v) { return __hip_atomic_fetch_add(p, v, __ATOMIC_RELAXED, __HIP_MEMORY_SCOPE_AGENT); }
__device__ __forceinline__ unsigned xb_xcc_id() { return (unsigned)__builtin_amdgcn_s_getreg((3 << 11) | 20) & 0xFu; }
#define XB_SPIN(cond, bar) do { unsigned _sp = 0; while (cond) { __builtin_amdgcn_s_sleep(1); \
    if ((++_sp & 255u) == 0u) { if (xb_ld(&(bar)[XB_TMO])) break; if (_sp > XB_SPIN_CAP) { atomicAdd(&(bar)[XB_TMO], 1u); break; } } } } while (0)
struct XcdBarrier { unsigned* bar; unsigned x; volatile LAS unsigned* st; };
__device__ __forceinline__ XcdBarrier xcd_barrier_post(unsigned* bar, volatile LAS unsigned* st) {
    XcdBarrier b; b.bar = bar; b.x = xb_xcc_id(); b.st = st;
    if (threadIdx.x == 0) (void)xb_add(&bar[XB_XCNT(b.x)], 1u);
    return b;
}
__device__ __forceinline__ void xcd_barrier_complete(unsigned* bar, unsigned x, unsigned& nloc, unsigned& nx) {
    const unsigned G = gridDim.x * gridDim.y * gridDim.z;
    unsigned sum, cnt, mine, sp = 0u;
    for (;;) {
        sum = 0u; cnt = 0u; mine = 0u;
#pragma unroll
        for (unsigned j = 0; j < 16; ++j) { const unsigned c = xb_ld(&bar[XB_XCNT(j)]); sum += c; cnt += (c > 0u) ? 1u : 0u; mine = (j == x) ? c : mine; }
        if (sum == G) break;
        __builtin_amdgcn_s_sleep(1);
        if ((++sp & 255u) == 0u) { if (xb_ld(&bar[XB_TMO])) break; if (sp > XB_SPIN_CAP) { atomicAdd(&bar[XB_TMO], 1u); break; } }
    }
    nloc = mine > 0u ? mine : 1u; nx = cnt > 0u ? cnt : 1u;
}
__device__ __forceinline__ void xcd_barrier(const XcdBarrier& b) {
    asm volatile("s_waitcnt vmcnt(0)" ::: "memory");
    __syncthreads();
    if (threadIdx.x == 0) {
        unsigned* bar = b.bar;
        __builtin_amdgcn_s_waitcnt(0);
        unsigned nloc = b.st[0], nx = b.st[1];
        if (nloc == 0u) { xcd_barrier_complete(bar, b.x, nloc, nx); b.st[0] = nloc; b.st[1] = nx; }
        const unsigned old = xb_add(&bar[XB_XSUB(b.x)], 1u);
        const unsigned gen = old / nloc;
        if (old + 1u == (gen + 1u) * nloc) {
            __builtin_amdgcn_fence(__ATOMIC_RELEASE, "agent");
            asm volatile("s_waitcnt vmcnt(0)" ::: "memory");
            const unsigned og = xb_add(&bar[XB_TOP], 1u);
            const unsigned tg = og / nx;
            if (og + 1u == (tg + 1u) * nx) xb_add(&bar[XB_TOPGEN], 1u);
            else XB_SPIN(xb_ld(&bar[XB_TOPGEN]) == tg, bar);
            __builtin_amdgcn_fence(__ATOMIC_ACQUIRE, "agent");
            xb_add(&bar[XB_XGEN(b.x)], 1u);
            asm volatile("s_waitcnt vmcnt(0)" ::: "memory");
        } else {
            XB_SPIN(xb_ld(&bar[XB_XGEN(b.x)]) == gen, bar);
            __builtin_amdgcn_fence(__ATOMIC_ACQUIRE, "agent");
            asm volatile("s_waitcnt vmcnt(0)" ::: "memory");
        }
    }
    __syncthreads();
}

__global__ void __launch_bounds__(NTHR, 2) fwd_megakernel(Args args) {
    extern __shared__ __attribute__((aligned(16))) unsigned char lds_raw[];
    LAS unsigned char* lds = (LAS unsigned char*)lds_raw;
    cg::grid_group grid = cg::this_grid();
    const int tid = threadIdx.x, lane = tid & 63, wid = __builtin_amdgcn_readfirstlane(tid >> 6);
    const int G = gridDim.x, bx = blockIdx.x;
    const int vcu = (G % 8 == 0) ? (bx % 8) * (G / 8) + bx / 8 : bx;
    const int gw = vcu * NWAVES + wid, NGW = G * NWAVES;
    unsigned char* ws = args.ws;
    const float* x = args.in[0]; const float* meta_tokens = args.in[1]; const float* mix_norm = args.in[2]; const float* w_in = args.in[3];
    const float* na_rpb = args.in[4]; const float* lq1 = args.in[5]; const float* lk1 = args.in[6]; const float* lq2 = args.in[7]; const float* lk2 = args.in[8];
    const float* diff_subln = args.in[9]; const float* w_na_out = args.in[10]; const float* w_diff_out = args.in[11]; const float* w_o = args.in[12];
    const float* ffn_norm = args.in[13]; const float* w_gate = args.in[14]; const float* w_up = args.in[15]; const float* w_down = args.in[16]; const float* final_norm = args.in[17];
    bf16_t* WinA = (bf16_t*)(ws + WS_WINA); bf16_t* WinV = (bf16_t*)(ws + WS_WINV); bf16_t* Wm = (bf16_t*)(ws + WS_WM); bf16_t* Wo = (bf16_t*)(ws + WS_WO);
    bf16_t* Wgu = (bf16_t*)(ws + WS_WGU); bf16_t* Wd = (bf16_t*)(ws + WS_WD);
    float* ropeC = (float*)(ws + WS_ROPEC); float* ropeS = (float*)(ws + WS_ROPES);
    bf16_t* naKm = (bf16_t*)(ws + WS_NAKM); bf16_t* dfKm = (bf16_t*)(ws + WS_DFKM); bf16_t* naVTm = (bf16_t*)(ws + WS_NAVTM); bf16_t* dfVTm = (bf16_t*)(ws + WS_DFVTM);
    bf16_t* XN = (bf16_t*)(ws + WS_XN); bf16_t* naQ = (bf16_t*)(ws + WS_NAQ); bf16_t* naK = (bf16_t*)(ws + WS_NAK); bf16_t* dfQ = (bf16_t*)(ws + WS_DFQ); bf16_t* dfK = (bf16_t*)(ws + WS_DFK);
    bf16_t* VT = (bf16_t*)(ws + WS_VT); bf16_t* ACT = (bf16_t*)(ws + WS_ACT); bf16_t* Gna = (bf16_t*)(ws + WS_GNA); bf16_t* Gdf = (bf16_t*)(ws + WS_GDF); bf16_t* AO = (bf16_t*)(ws + WS_AO);
    bf16_t* MG = XN; bf16_t* H2 = XN;
    bf16_t* X1b = Gna; bf16_t* X2b = Gdf;
    float* out = args.out;
    const int lo = args.ph_lo, hi = args.ph_hi;
#define IN(k) (lo <= (k) && (k) < hi)
    volatile LAS unsigned* MISC = (volatile LAS unsigned*)(lds + LDS_BYTES - 64);
    if (tid < 16) MISC[tid] = 0u;
    __syncthreads();
    XcdBarrier xbar = xcd_barrier_post((unsigned*)(ws + WS_CTL), MISC);
    if (args.ph_lo > 1000) grid.sync();
#define SEAM(k) do { if (IN(k) && IN((k) + 1)) xcd_barrier(xbar); } while (0)

    if (IN(0)) {
        {
            LAS float* scr = (LAS float*)(lds + wid * 16384);
            constexpr int I_A = 128 * 16, I_V = 32 * 16, I_M = 32 * 16, I_O = 32 * 16, I_GU = 176 * 16, I_D = 32 * 44;
            constexpr int NITEMS = I_A + I_V + I_M + I_O + I_GU + I_D;
            for (int it = gw; it < NITEMS; it += NGW) {
                int q = it;
                if (q < I_A) { const int kb = q >> 7, nb = q & 127, tile = nb >> 3, bb = nb & 7; int src;
                    if (tile < 4) src = tile * 256 + bb * 32;
                    else if (tile < 8) { const int base = (tile < 6 ? 1536 : 2048) + (tile & 1) * 256; src = base + (bb & 3) * 64 + (bb >> 2) * 32; }
                    else src = (bb < 4 ? 3072 : 4096) + (tile - 8) * 128 + (bb & 3) * 32;
                    transpose_block(w_in, INCOLS, kb * 64, src, WinA, DM, nb * 32, kb * 64, scr, lane, nullptr, 1.f); continue; }
                q -= I_A;
                if (q < I_V) { const int kb = q >> 5, nb = q & 31; const int src = nb < 16 ? 1024 + nb * 32 : 2560 + (nb - 16) * 32;
                    transpose_block(w_in, INCOLS, kb * 64, src, WinV, DM, nb * 32, kb * 64, scr, lane, nullptr, 1.f); continue; }
                q -= I_V;
                if (q < I_M) { const int kb = q >> 5, nb = q & 31;
                    if (kb < 8) transpose_block(w_na_out, DM, kb * 64, nb * 32, Wm, DM, nb * 32, kb * 64, scr, lane, nullptr, 1.f);
                    else transpose_block(w_diff_out, DM, (kb - 8) * 64, nb * 32, Wm, DM, nb * 32, kb * 64, scr, lane, diff_subln, 0.8f);
                    continue; }
                q -= I_M;
                if (q < I_O) { const int kb = q >> 5, nb = q & 31; transpose_block(w_o, DM, kb * 64, nb * 32, Wo, DM, nb * 32, kb * 64, scr, lane, nullptr, 1.f); continue; }
                q -= I_O;
                if (q < I_GU) { const int kb = q / 176, nb = q - kb * 176, tile = nb >> 3, bb = nb & 7;
                    if (bb < 4) transpose_block(w_gate, DFF, kb * 64, tile * 128 + bb * 32, Wgu, DM, nb * 32, kb * 64, scr, lane, ffn_norm, 1.f, 1023);
                    else transpose_block(w_up, DFF, kb * 64, tile * 128 + (bb - 4) * 32, Wgu, DM, nb * 32, kb * 64, scr, lane, ffn_norm, 1.f, 1023);
                    continue; }
                q -= I_GU;
                { const int kb = q >> 5, nb = q & 31; transpose_block(w_down, DM, kb * 64, nb * 32, Wd, DFF, nb * 32, kb * 64, scr, lane, nullptr, 1.f); }
            }
        }
        for (int e = bx * NTHR + tid; e < (SEQ + NMETA) * 32; e += G * NTHR) { float c, s; rope_cs(e >> 5, e & 31, c, s); ropeC[e] = c; ropeS[e] = s; }
        { unsigned* z = (unsigned*)(ws + WS_NAKM); constexpr int NZ = (int)((WS_DFVTM + 64 * 1024 - WS_NAKM) / 4);
          for (int e = bx * NTHR + tid; e < NZ; e += G * NTHR) {
              const size_t byte = (size_t)e * 4 + WS_NAKM; bool valid;
              if (byte < WS_DFKM) valid = (byte - WS_NAKM) < 16 * 1024;
              else if (byte < WS_NAVTM) valid = (byte - WS_DFKM) < 16 * 1024;
              else if (byte < WS_DFVTM) valid = ((byte - WS_NAVTM) & 63) < 32;
              else valid = ((byte - WS_DFVTM) & 127) < 32;
              if (!valid) z[e] = 0u; } }
        __syncthreads();
        {
            LAS float* hmT = (LAS float*)lds;
            LAS float* red = (LAS float*)(lds + 65536);
            for (int rr = 0; rr < 2; ++rr) { const int row = 2 * wid + rr;
                const f32x4* xr = (const f32x4*)(meta_tokens + row * DM) + lane; f32x4 v[4]; float s = 0.f;
#pragma unroll
                for (int j = 0; j < 4; ++j) { v[j] = xr[64 * j]; s += (v[j].x * v[j].x + v[j].y * v[j].y) + (v[j].z * v[j].z + v[j].w * v[j].w); }
                const float rstd = 1.0f / sqrtf(wave_sum(s) * (1.0f / DM) + 1e-6f);
#pragma unroll
                for (int j = 0; j < 4; ++j) { const int k = 4 * lane + 256 * j; const f32x4 g = *(const f32x4*)(mix_norm + k);
                    hmT[(k + 0) * 16 + row] = pg8::bf_lo(cvt_pk_bf16(v[j].x * rstd * g.x, 0.f)); hmT[(k + 1) * 16 + row] = pg8::bf_lo(cvt_pk_bf16(v[j].y * rstd * g.y, 0.f));
                    hmT[(k + 2) * 16 + row] = pg8::bf_lo(cvt_pk_bf16(v[j].z * rstd * g.z, 0.f)); hmT[(k + 3) * 16 + row] = pg8::bf_lo(cvt_pk_bf16(v[j].w * rstd * g.w, 0.f)); } }
            __syncthreads();
            for (int Gc = bx; Gc < 256; Gc += G) {
                const int region = Gc >> 6, gi = Gc & 63, chunk = gi >> 3, sub = gi & 7;
                const int ci = tid & 7, row = (tid >> 3) & 15, kq = tid >> 7;
                const int lcol = chunk * 64 + sub * 4 + (ci & 3) + 32 * (ci >> 2);
                const int rbase = region == 0 ? 512 : region == 1 ? 1024 : region == 2 ? 2048 : 2560;
                const float* wp = w_in + (size_t)(kq * 256) * INCOLS + rbase + lcol;
                float a = 0.f;
#pragma unroll 32
                for (int k = 0; k < 256; ++k) a += hmT[(kq * 256 + k) * 16 + row] * wp[(size_t)k * INCOLS];
                red[(kq * 16 + row) * 8 + ci] = a;
                __syncthreads();
                if (tid < 128) {
                    const int p = ci & 3, hf = ci >> 2;
                    const float v1 = red[(0 * 16 + row) * 8 + p] + red[(1 * 16 + row) * 8 + p] + red[(2 * 16 + row) * 8 + p] + red[(3 * 16 + row) * 8 + p];
                    const float v2 = red[(0 * 16 + row) * 8 + p + 4] + red[(1 * 16 + row) * 8 + p + 4] + red[(2 * 16 + row) * 8 + p + 4] + red[(3 * 16 + row) * 8 + p + 4];
                    float val = hf ? v2 : v1;
                    if (region == 2) { float c, s; rope_cs(row, sub * 4 + p, c, s); val = hf ? (v2 * c + v1 * s) : (v1 * c - v2 * s); }
                    const bf16_t bv = (bf16_t)(cvt_pk_bf16(val, 0.f) & 0xffffu);
                    if (region == 0) naKm[row * 512 + lcol] = bv;
                    else if (region == 1) naVTm[lcol * 32 + row] = bv;
                    else if (region == 2) dfKm[row * 512 + lcol] = bv;
                    else dfVTm[lcol * 64 + row] = bv;
                }
                __syncthreads();
            }
        }
        { f32x4 g[4];
#pragma unroll
          for (int j = 0; j < 4; ++j) g[j] = *((const f32x4*)mix_norm + lane + 64 * j);
          for (int m = gw; m < MTOK; m += NGW) rms_row_bf16(x + (size_t)m * DM, g, XN + (size_t)m * DM, lane, 1e-6f); }
    }
    SEAM(0);

    if (IN(1)) {
        { pg8::Gemm g{XN, WinA, MTOK, 4096, DM}; pg8::StaticOrder S; S.init(MTOK, 4096, G, bx);
          pg8::EpiProj E{naQ, naK, dfQ, dfK, Gna, Gdf, ropeC, ropeS};
          pg8::gemm_phase<pg8::EpiProj, pg8::StaticOrder, true, true>(lds, g, S, E); }
        { pg8::Gemm g{WinV, XN, 1024, MTOK, DM}; pg8::StaticOrder S; S.init(1024, MTOK, G, bx);
          pg8::EpiVT E{VT};
          pg8::gemm_phase<pg8::EpiVT, pg8::StaticOrder, true, true>(lds, g, S, E); }
    }
    SEAM(1);

    if (IN(2)) {
        float lam;
        { const float a = wave_sum(lq1[lane] * lk1[lane]), bb = wave_sum(lq2[lane] * lk2[lane]); lam = expf(a) - expf(bb) + 0.2f; }
        for (int u = 2 * vcu; u < NB * 4 * 32; u += 2 * G) {
            for (int uu = u; uu < u + 2; ++uu) { const int bh = uu >> 5, qb = uu & 31; diff_unit(bh >> 2, bh & 3, qb, dfQ, dfK, VT, dfKm, dfVTm, AO, lam, lds, wid, lane); }
        }
        { LAS float* rpbL = (LAS float*)(lds + 131072);
          for (int e = tid; e < 8 * 465 + 2 * NA_RPB_PAD; e += NTHR) { const int t = e - NA_RPB_PAD; rpbL[e] = (t >= 0 && t < 8 * 465) ? na_rpb[t] * LOG2E : 0.f; }
          __syncthreads();
          for (int u = 4 * vcu; u < 1024; u += 4 * G)
              for (int uu = u; uu < u + 4; ++uu) { const int hq = uu & 1, gr = (uu >> 1) & 127, b = uu >> 8;
                  na_unit(b, hq * 4 + (wid >> 1), gr, wid & 1, naQ, naK, VT, naKm, naVTm, AO, rpbL, lds + wid * 8192, lane); }
          __syncthreads(); }
    }
    SEAM(2);

    if (IN(3)) {
        pg8::Gemm g{AO, Wm, MTOK, DM, DM}; pg8::StaticOrder S; S.init(MTOK, DM, G, bx);
        pg8::EpiMerge E{Gna, Gdf, MG};
        pg8::gemm_phase<pg8::EpiMerge, pg8::StaticOrder, true, true>(lds, g, S, E);
    }
    SEAM(3);

    if (IN(4)) {
        pg8::Gemm g{MG, Wo, MTOK, DM, DM}; pg8::StaticOrder S; S.init(MTOK, DM, G, bx);
        pg8::EpiResidF32toB E{x, X1b};
        pg8::gemm_phase<pg8::EpiResidF32toB, pg8::StaticOrder, true, true>(lds, g, S, E);
    }
    SEAM(4);

    if (IN(5)) {
        float* rstdv = (float*)(ws + WS_RSTD);
        for (int m = gw; m < MTOK; m += NGW) {
            const u32x4 a = *((const u32x4*)(X1b + (size_t)m * DM) + lane), b = *((const u32x4*)(X1b + (size_t)m * DM) + 64 + lane);
            float s = 0.f;
            { const unsigned wv[8] = {a.x, a.y, a.z, a.w, b.x, b.y, b.z, b.w};
#pragma unroll
              for (int j = 0; j < 8; ++j) { const float lo = pg8::bf_lo(wv[j]), hi = pg8::bf_hi(wv[j]); s += lo * lo + hi * hi; } }
            const float tot = wave_sum(s);
            if (lane == 0) rstdv[m] = 1.0f / sqrtf(tot * (1.0f / DM) + 1e-6f);
        }
    }
    SEAM(5);

    if (IN(6)) {
        pg8::Gemm g{X1b, Wgu, MTOK, 2 * DFF, DM}; pg8::StaticOrder S; S.init(MTOK, 2 * DFF, G, bx);
        pg8::EpiSwiGLU E{ACT, (const float*)(ws + WS_RSTD)};
        pg8::gemm_phase<pg8::EpiSwiGLU, pg8::StaticOrder, true, true>(lds, g, S, E);
    }
    SEAM(6);

    if (IN(7)) {
        pg8::Gemm g{ACT, Wd, MTOK, DM, DFF}; pg8::StaticOrder S; S.init(MTOK, DM, G, bx);
        pg8::EpiResidBtoB E{X1b, X2b};
        pg8::gemm_phase<pg8::EpiResidBtoB, pg8::StaticOrder, true, true>(lds, g, S, E);
    }
    SEAM(7);

    if (IN(8)) {
        for (int m = gw; m < MTOK; m += NGW) rms_rowb_f32(X2b + (size_t)m * DM, final_norm, out + (size_t)m * DM, lane, 1e-6f);
    }
#undef IN
#undef SEAM
}

extern "C" void kernel_launch(void* const* d_in, const int* in_sizes, int n_in, void* d_out, int out_size, void* d_ws, size_t ws_size, hipStream_t stream) {
    static int grid = 0;
    if (grid == 0) {
        if (n_in != 18 || out_size != MTOK * DM || ws_size < WS_END) { fprintf(stderr, "kernel_launch: unexpected problem (n_in %d, out %d, ws %zu)\n", n_in, out_size, ws_size); grid = -1; return; }
        int dev = 0, cus = 0, per_cu = 0;
        hipGetDevice(&dev);
        hipDeviceGetAttribute(&cus, hipDeviceAttributeMultiprocessorCount, dev);
        hipFuncSetAttribute((const void*)fwd_megakernel, hipFuncAttributeMaxDynamicSharedMemorySize, LDS_BYTES);
        hipOccupancyMaxActiveBlocksPerMultiprocessor(&per_cu, (const void*)fwd_megakernel, NTHR, LDS_BYTES);
        if (per_cu < 1) { fprintf(stderr, "kernel_launch: occupancy query says %d blocks per CU\n", per_cu); per_cu = 1; }
        (void)hipGetLastError();
        grid = cus;
    }
    if (grid < 0) return;
    if (hipMemsetAsync((char*)d_ws + WS_CTL, 0, CTL_BYTES, stream) != hipSuccess) { fprintf(stderr, "kernel_launch: memset of control words failed\n"); return; }
    Args a{};
    for (int i = 0; i < 18; ++i) a.in[i] = (const float*)d_in[i];
    a.out = (float*)d_out; a.ws = (unsigned char*)d_ws; a.ph_lo = 0; a.ph_hi = 9;
    void* kargs[] = {&a};
    hipError_t e = hipLaunchCooperativeKernel((const void*)fwd_megakernel, dim3(grid), dim3(NTHR), kargs, LDS_BYTES, stream);
    if (e != hipSuccess) fprintf(stderr, "cooperative launch failed: %s (grid %d)\n", hipGetErrorString(e), grid);
}
```

```cpp
#include <hip/hip_runtime.h>
#include <hip/hip_cooperative_groups.h>
#include <cstdio>
#include <cstdint>
namespace cg = cooperative_groups;

#define LAS __attribute__((address_space(3)))
typedef unsigned short bf16_t;
typedef short bf16x8 __attribute__((ext_vector_type(8)));
typedef float f32x4 __attribute__((ext_vector_type(4)));
typedef float f32x2 __attribute__((ext_vector_type(2)));
typedef float f32x16 __attribute__((ext_vector_type(16)));
typedef unsigned u32x4 __attribute__((ext_vector_type(4)));
typedef unsigned u32x2 __attribute__((ext_vector_type(2)));
typedef __bf16 bf16x2_t __attribute__((ext_vector_type(2)));

constexpr int DM = 1024, NB = 4, SEQ = 8192, MTOK = NB * SEQ;
constexpr int NMETA = 16, DFF = 2816, INCOLS = 5120;
constexpr float C2 = 0.125f * 1.4426950408889634f;
constexpr float LOG2E = 1.4426950408889634f;

constexpr size_t MiB = (size_t)1 << 20;
constexpr size_t WS_WINA = 0;
constexpr size_t WS_WINV = 8 * MiB;
constexpr size_t WS_WM = 10 * MiB;
constexpr size_t WS_WO = 12 * MiB;
constexpr size_t WS_WGU = 14 * MiB;
constexpr size_t WS_WD = 25 * MiB;
constexpr size_t WS_ROPEC = 31 * MiB;
constexpr size_t WS_ROPES = 32 * MiB + 512 * 1024;
constexpr size_t WS_NAKM = 34 * MiB;
constexpr size_t WS_DFKM = WS_NAKM + 64 * 1024;
constexpr size_t WS_NAVTM = WS_DFKM + 128 * 1024;
constexpr size_t WS_DFVTM = WS_NAVTM + 64 * 1024;
constexpr size_t WS_XN = 36 * MiB;
constexpr size_t WS_NAQ = 100 * MiB, WS_NAK = 132 * MiB, WS_DFQ = 164 * MiB, WS_DFK = 196 * MiB;
constexpr size_t WS_VT = 228 * MiB;
constexpr size_t WS_ACT = 100 * MiB;
constexpr size_t WS_GNA = 292 * MiB, WS_GDF = 356 * MiB;
constexpr size_t WS_AO = 420 * MiB;
constexpr size_t WS_CTL = 484 * MiB, CTL_BYTES = 64 * 1024;
constexpr size_t WS_RSTD = 485 * MiB;
constexpr size_t WS_END = 486 * MiB;

namespace pg8 {
constexpr int BM = 256, BK = 64, HALF = 128, HTB = HALF * BK * 2, STAGE_BYTES = 8 * HTB, NXCD = 8, WGM = 8;
__host__ __device__ __forceinline__ int lds_byte(int r, int c) { const int st = (r >> 4) * 2 + (c >> 5), rr = r & 15, cc = c & 31, ob = rr * 64 + cc * 2; return st * 1024 + (ob ^ (((ob >> 9) & 1) << 5)); }
__host__ __device__ __forceinline__ void stage_rc(int b, int& R, int& C) { const int st = b / 1024, sb = b % 1024, swz = sb ^ (((sb >> 9) & 1) << 5); R = (st >> 1) * 16 + swz / 64; C = (st & 1) * 32 + (swz % 64) / 2; }
__host__ __device__ __forceinline__ int perm32(int rho) { const int n = rho >> 4, i = rho & 15; return 8 * (i >> 2) + 4 * n + (i & 3); }

struct Unit { int pm, pn; };
struct Gemm { const bf16_t* A; const bf16_t* Bt; int M, N, K; };

struct StaticOrder {
    int nM, nN, nwg, G, c;
    __host__ __device__ void init(int M, int N, int G_, int c_) { nM = M / BM; nN = N / BM; nwg = nM * nN; G = G_; c = c_; }
    __host__ __device__ bool next(int i, Unit& u) const {
        const long L = (long)i * G + c; if (L >= nwg) return false;
        int wgid = (int)L; { const int q = nwg / NXCD, r = nwg % NXCD, xcd = wgid % NXCD, off = wgid / NXCD; wgid = (xcd < r ? xcd * (q + 1) : r * (q + 1) + (xcd - r) * q) + off; }
        const int nig = WGM * nN, gid = wgid / nig, fm = gid * WGM, gsz = (nM - fm) < WGM ? (nM - fm) : WGM;
        u.pm = fm + ((wgid % nig) % gsz); u.pn = (wgid % nig) / gsz; return true;
    }
};

__device__ __forceinline__ unsigned cvt_pk_bf16(float lo, float hi) { f32x2 v = {lo, hi}; bf16x2_t b = __builtin_convertvector(v, bf16x2_t); return __builtin_bit_cast(unsigned, b); }
__device__ __forceinline__ float bf_lo(unsigned w) { return __uint_as_float(w << 16); }
__device__ __forceinline__ float bf_hi(unsigned w) { return __uint_as_float(w & 0xffff0000u); }
__device__ __forceinline__ float sigmoidf_fast(float x) { return __builtin_amdgcn_rcpf(1.0f + __builtin_amdgcn_exp2f(-x * LOG2E)); }


struct EpiBf16 {
    static constexpr bool PERM = true, HAS_MID = false;
    bf16_t* O; int ldc;
    __device__ __forceinline__ void mid(f32x4 (&)[2][2][4][2], const Unit&, int, int, int, int) const {}
    __device__ __forceinline__ void operator()(const f32x4 (&acc)[2][2][4][2], const Unit& u, int wr, int wc, int fr, int fq) const {
        const int row0 = u.pm * BM + wr * 64 + fr, col0 = u.pn * BM + wc * 32 + 8 * fq;
#pragma unroll
        for (int ai = 0; ai < 2; ++ai)
#pragma unroll
            for (int m = 0; m < 4; ++m) { bf16_t* rowp = O + (size_t)(row0 + ai * HALF + m * 16) * ldc + col0;
#pragma unroll
                for (int bj = 0; bj < 2; ++bj) { const f32x4 v0 = acc[ai][bj][m][0], v1 = acc[ai][bj][m][1];
                    u32x4 w; w.x = cvt_pk_bf16(v0[0], v0[1]); w.y = cvt_pk_bf16(v0[2], v0[3]); w.z = cvt_pk_bf16(v1[0], v1[1]); w.w = cvt_pk_bf16(v1[2], v1[3]);
                    *(u32x4*)(rowp + bj * HALF) = w; } }
    }
};

struct EpiVT {
    static constexpr bool PERM = true, HAS_MID = false;
    bf16_t* VT;
    __device__ __forceinline__ void mid(f32x4 (&)[2][2][4][2], const Unit&, int, int, int, int) const {}
    __device__ __forceinline__ void operator()(const f32x4 (&acc)[2][2][4][2], const Unit& u, int wr, int wc, int fr, int fq) const {
        const int ch0 = u.pm * BM + wr * 64 + fr, tok0 = u.pn * BM + wc * 32 + 8 * fq;
#pragma unroll
        for (int ai = 0; ai < 2; ++ai)
#pragma unroll
            for (int m = 0; m < 4; ++m) { const int ch = ch0 + ai * HALF + m * 16;
#pragma unroll
                for (int bj = 0; bj < 2; ++bj) { const int tok = tok0 + bj * HALF; const int b = tok >> 13, blk = (tok >> 6) & 127, k = tok & 63;
                    size_t off;
                    if (ch < 512) off = (size_t)((b * 8 + (ch >> 6)) * 128 + blk) * 4096 + (k >> 4) * 1024 + (ch & 63) * 16 + (k & 15);
                    else { const int c2 = ch - 512; off = (size_t)16777216 + ((size_t)((b * 4 + (c2 >> 7)) * 128 + blk) * 128 + (c2 & 127)) * 64 + k; }
                    const f32x4 v0 = acc[ai][bj][m][0], v1 = acc[ai][bj][m][1];
                    u32x4 w; w.x = cvt_pk_bf16(v0[0], v0[1]); w.y = cvt_pk_bf16(v0[2], v0[3]); w.z = cvt_pk_bf16(v1[0], v1[1]); w.w = cvt_pk_bf16(v1[2], v1[3]);
                    *(u32x4*)(VT + off) = w; } }
    }
};

struct EpiProj {
    static constexpr bool PERM = true, HAS_MID = false;
    bf16_t *naQ, *naK, *dfQ, *dfK, *Gna, *Gdf; const float *ropeC, *ropeS;
    __device__ __forceinline__ void mid(f32x4 (&)[2][2][4][2], const Unit&, int, int, int, int) const {}
    __device__ __forceinline__ void operator()(const f32x4 (&acc)[2][2][4][2], const Unit& u, int wr, int wc, int fr, int fq) const {
        const int tile = u.pn; const int row0 = u.pm * BM + wr * 64 + fr;
        if (tile >= 8) {
            const int col0 = (tile - 8) * 128 + wc * 32 + 8 * fq;
#pragma unroll
            for (int ai = 0; ai < 2; ++ai)
#pragma unroll
                for (int m = 0; m < 4; ++m) { const size_t off = (size_t)(row0 + ai * HALF + m * 16) * DM + col0;
                    f32x4 rr[2], sd[2];
#pragma unroll
                    for (int n = 0; n < 2; ++n)
#pragma unroll
                        for (int j = 0; j < 4; ++j) { const float ena = __builtin_amdgcn_exp2f(fminf(-acc[ai][0][m][n][j] * LOG2E, 100.f)), edf = __builtin_amdgcn_exp2f(fminf(-acc[ai][1][m][n][j] * LOG2E, 100.f));
                            rr[n][j] = (1.0f + edf) * __builtin_amdgcn_rcpf(1.0f + ena); sd[n][j] = __builtin_amdgcn_rcpf(1.0f + edf); }
                    u32x4 w; w.x = cvt_pk_bf16(rr[0][0], rr[0][1]); w.y = cvt_pk_bf16(rr[0][2], rr[0][3]); w.z = cvt_pk_bf16(rr[1][0], rr[1][1]); w.w = cvt_pk_bf16(rr[1][2], rr[1][3]);
                    __builtin_nontemporal_store(w, (u32x4*)(Gna + off));
                    w.x = cvt_pk_bf16(sd[0][0], sd[0][1]); w.y = cvt_pk_bf16(sd[0][2], sd[0][3]); w.z = cvt_pk_bf16(sd[1][0], sd[1][1]); w.w = cvt_pk_bf16(sd[1][2], sd[1][3]);
                    __builtin_nontemporal_store(w, (u32x4*)(Gdf + off)); }
        } else if (tile < 4) {
            bf16_t* base; int ldc, colt, mode;
            if (tile < 2) { base = naQ; ldc = 512; colt = tile * 256; mode = 1; }
            else { base = naK; ldc = 512; colt = (tile - 2) * 256; mode = 0; }
            const int col0 = colt + wc * 32 + 8 * fq;
#pragma unroll
            for (int ai = 0; ai < 2; ++ai)
#pragma unroll
                for (int m = 0; m < 4; ++m) { bf16_t* rowp = base + (size_t)(row0 + ai * HALF + m * 16) * ldc + col0;
#pragma unroll
                    for (int bj = 0; bj < 2; ++bj) { f32x4 v0 = acc[ai][bj][m][0], v1 = acc[ai][bj][m][1];
                        if (mode == 1) { v0 = v0 * C2; v1 = v1 * C2; }
                        u32x4 w; w.x = cvt_pk_bf16(v0[0], v0[1]); w.y = cvt_pk_bf16(v0[2], v0[3]); w.z = cvt_pk_bf16(v1[0], v1[1]); w.w = cvt_pk_bf16(v1[2], v1[3]);
                        *(u32x4*)(rowp + bj * HALF) = w; } }
        } else {
            bf16_t* base = tile < 6 ? dfQ : dfK; const float sc = tile < 6 ? C2 : 1.0f;
            const int cb = ((tile & 1) * 4 + wc) * 64 + 8 * fq;
#pragma unroll
            for (int ai = 0; ai < 2; ++ai)
#pragma unroll
                for (int m = 0; m < 4; ++m) { const int row = row0 + ai * HALF + m * 16; const int pos = NMETA + (row & (SEQ - 1));
                    const f32x4 c0 = *(const f32x4*)(ropeC + pos * 32 + 8 * fq), c1 = *(const f32x4*)(ropeC + pos * 32 + 8 * fq + 4);
                    const f32x4 s0 = *(const f32x4*)(ropeS + pos * 32 + 8 * fq), s1 = *(const f32x4*)(ropeS + pos * 32 + 8 * fq + 4);
                    const f32x4 x10 = acc[ai][0][m][0], x11 = acc[ai][0][m][1], x20 = acc[ai][1][m][0], x21 = acc[ai][1][m][1];
                    const f32x4 a0 = (x10 * c0 - x20 * s0) * sc, a1 = (x11 * c1 - x21 * s1) * sc;
                    const f32x4 b0 = (x20 * c0 + x10 * s0) * sc, b1 = (x21 * c1 + x11 * s1) * sc;
                    bf16_t* rowp = base + (size_t)row * 512 + cb;
                    u32x4 w; w.x = cvt_pk_bf16(a0[0], a0[1]); w.y = cvt_pk_bf16(a0[2], a0[3]); w.z = cvt_pk_bf16(a1[0], a1[1]); w.w = cvt_pk_bf16(a1[2], a1[3]);
                    *(u32x4*)(rowp) = w;
                    w.x = cvt_pk_bf16(b0[0], b0[1]); w.y = cvt_pk_bf16(b0[2], b0[3]); w.z = cvt_pk_bf16(b1[0], b1[1]); w.w = cvt_pk_bf16(b1[2], b1[3]);
                    *(u32x4*)(rowp + 32) = w; }
        }
    }
};

struct EpiMerge {
    static constexpr bool PERM = true, HAS_MID = true;
    const bf16_t *Rat, *Sdf; bf16_t* MG;
    __device__ __forceinline__ void mid(f32x4 (&acc)[2][2][4][2], const Unit& u, int wr, int wc, int fr, int fq) const {
        int row0 = u.pm * BM + wr * 64 + fr; const int col0 = u.pn * BM + wc * 32 + 8 * fq;
        asm volatile("" : "+v"(row0));
        const unsigned o = (unsigned)(row0 * DM + col0) * 2u; const char* rb = (const char*)Rat;
#pragma unroll
        for (int ai = 0; ai < 2; ++ai)
#pragma unroll
            for (int m = 0; m < 4; ++m) {
#pragma unroll
                for (int bj = 0; bj < 2; ++bj) { const u32x4 a = __builtin_nontemporal_load((const u32x4*)(rb + (o + (unsigned)(((ai * HALF + m * 16) * DM + bj * HALF) * 2))));
                    acc[ai][bj][m][0][0] *= bf_lo(a.x); acc[ai][bj][m][0][1] *= bf_hi(a.x); acc[ai][bj][m][0][2] *= bf_lo(a.y); acc[ai][bj][m][0][3] *= bf_hi(a.y);
                    acc[ai][bj][m][1][0] *= bf_lo(a.z); acc[ai][bj][m][1][1] *= bf_hi(a.z); acc[ai][bj][m][1][2] *= bf_lo(a.w); acc[ai][bj][m][1][3] *= bf_hi(a.w);
                    asm volatile("" ::: "memory"); } }
    }
    __device__ __forceinline__ void operator()(const f32x4 (&acc)[2][2][4][2], const Unit& u, int wr, int wc, int fr, int fq) const {
        const int row0 = u.pm * BM + wr * 64 + fr, col0 = u.pn * BM + wc * 32 + 8 * fq;
#pragma unroll
        for (int ai = 0; ai < 2; ++ai)
#pragma unroll
            for (int m = 0; m < 4; ++m) { const size_t off = (size_t)(row0 + ai * HALF + m * 16) * DM + col0;
#pragma unroll
                for (int bj = 0; bj < 2; ++bj) { const u32x4 d = __builtin_nontemporal_load((const u32x4*)(Sdf + off + bj * HALF));
                    const f32x4 v0 = acc[ai][bj][m][0], v1 = acc[ai][bj][m][1];
                    u32x4 w; w.x = cvt_pk_bf16(v0[0] * bf_lo(d.x), v0[1] * bf_hi(d.x)); w.y = cvt_pk_bf16(v0[2] * bf_lo(d.y), v0[3] * bf_hi(d.y));
                    w.z = cvt_pk_bf16(v1[0] * bf_lo(d.z), v1[1] * bf_hi(d.z)); w.w = cvt_pk_bf16(v1[2] * bf_lo(d.w), v1[3] * bf_hi(d.w));
                    *(u32x4*)(MG + off + bj * HALF) = w; }
                asm volatile("" ::: "memory"); }
    }
};

struct EpiResid {
    static constexpr bool PERM = false, HAS_MID = false;
    const float* base; float* out;
    __device__ __forceinline__ void mid(f32x4 (&)[2][2][4][2], const Unit&, int, int, int, int) const {}
    __device__ __forceinline__ void operator()(const f32x4 (&acc)[2][2][4][2], const Unit& u, int wr, int wc, int fr, int fq) const {
        const int row0 = u.pm * BM + wr * 64 + fr, col0 = u.pn * BM + wc * 32 + 4 * fq;
#pragma unroll
        for (int ai = 0; ai < 2; ++ai)
#pragma unroll
            for (int m = 0; m < 4; ++m) { const size_t off = (size_t)(row0 + ai * HALF + m * 16) * DM + col0;
#pragma unroll
                for (int bj = 0; bj < 2; ++bj)
#pragma unroll
                    for (int n = 0; n < 2; ++n) { const f32x4 bs = *(const f32x4*)(base + off + bj * HALF + n * 16); *(f32x4*)(out + off + bj * HALF + n * 16) = bs + acc[ai][bj][m][n]; }
                if (m & 1) asm volatile("" ::: "memory"); }
    }
};

struct EpiResidF32toB {
    static constexpr bool PERM = true, HAS_MID = false;
    const float* base; bf16_t* outb;
    __device__ __forceinline__ void mid(f32x4 (&)[2][2][4][2], const Unit&, int, int, int, int) const {}
    __device__ __forceinline__ void operator()(const f32x4 (&acc)[2][2][4][2], const Unit& u, int wr, int wc, int fr, int fq) const {
        const int row0 = u.pm * BM + wr * 64 + fr, col0 = u.pn * BM + wc * 32 + 8 * fq;
#pragma unroll
        for (int ai = 0; ai < 2; ++ai)
#pragma unroll
            for (int m = 0; m < 4; ++m) { const size_t off = (size_t)(row0 + ai * HALF + m * 16) * DM + col0;
#pragma unroll
                for (int bj = 0; bj < 2; ++bj) { const f32x4 b0 = __builtin_nontemporal_load((const f32x4*)(base + off + bj * HALF)), b1 = __builtin_nontemporal_load((const f32x4*)(base + off + bj * HALF + 4));
                    const f32x4 v0 = b0 + acc[ai][bj][m][0], v1 = b1 + acc[ai][bj][m][1];
                    u32x4 w; w.x = cvt_pk_bf16(v0[0], v0[1]); w.y = cvt_pk_bf16(v0[2], v0[3]); w.z = cvt_pk_bf16(v1[0], v1[1]); w.w = cvt_pk_bf16(v1[2], v1[3]);
                    *(u32x4*)(outb + off + bj * HALF) = w; }
                if (m & 1) asm volatile("" ::: "memory"); }
    }
};
struct EpiResidBtoB {
    static constexpr bool PERM = true, HAS_MID = false;
    const bf16_t* baseb; bf16_t* outb;
    __device__ __forceinline__ void mid(f32x4 (&)[2][2][4][2], const Unit&, int, int, int, int) const {}
    __device__ __forceinline__ void operator()(const f32x4 (&acc)[2][2][4][2], const Unit& u, int wr, int wc, int fr, int fq) const {
        const int row0 = u.pm * BM + wr * 64 + fr, col0 = u.pn * BM + wc * 32 + 8 * fq;
#pragma unroll
        for (int ai = 0; ai < 2; ++ai)
#pragma unroll
            for (int m = 0; m < 4; ++m) { const size_t off = (size_t)(row0 + ai * HALF + m * 16) * DM + col0;
#pragma unroll
                for (int bj = 0; bj < 2; ++bj) { const u32x4 b = __builtin_nontemporal_load((const u32x4*)(baseb + off + bj * HALF));
                    const f32x4 a0 = acc[ai][bj][m][0], a1 = acc[ai][bj][m][1];
                    u32x4 w; w.x = cvt_pk_bf16(bf_lo(b.x) + a0[0], bf_hi(b.x) + a0[1]); w.y = cvt_pk_bf16(bf_lo(b.y) + a0[2], bf_hi(b.y) + a0[3]);
                    w.z = cvt_pk_bf16(bf_lo(b.z) + a1[0], bf_hi(b.z) + a1[1]); w.w = cvt_pk_bf16(bf_lo(b.w) + a1[2], bf_hi(b.w) + a1[3]);
                    *(u32x4*)(outb + off + bj * HALF) = w; }
                if (m & 1) asm volatile("" ::: "memory"); }
    }
};

struct EpiSwiGLU {
    static constexpr bool PERM = true, HAS_MID = false;
    bf16_t* ACT; const float* rstdv;
    __device__ __forceinline__ void mid(f32x4 (&)[2][2][4][2], const Unit&, int, int, int, int) const {}
    __device__ __forceinline__ void operator()(const f32x4 (&acc)[2][2][4][2], const Unit& u, int wr, int wc, int fr, int fq) const {
        const int row0 = u.pm * BM + wr * 64 + fr, col0 = u.pn * HALF + wc * 32 + 8 * fq;
#pragma unroll
        for (int ai = 0; ai < 2; ++ai)
#pragma unroll
            for (int m = 0; m < 4; ++m) { const int row = row0 + ai * HALF + m * 16; bf16_t* rowp = ACT + (size_t)row * DFF + col0;
                const float rstd = rstdv[row];
                f32x4 g0 = acc[ai][0][m][0] * rstd, g1 = acc[ai][0][m][1] * rstd; const f32x4 u0 = acc[ai][1][m][0] * rstd, u1 = acc[ai][1][m][1] * rstd;
#pragma unroll
                for (int j = 0; j < 4; ++j) { g0[j] = g0[j] * sigmoidf_fast(g0[j]) * u0[j]; g1[j] = g1[j] * sigmoidf_fast(g1[j]) * u1[j]; }
                u32x4 w; w.x = cvt_pk_bf16(g0[0], g0[1]); w.y = cvt_pk_bf16(g0[2], g0[3]); w.z = cvt_pk_bf16(g1[0], g1[1]); w.w = cvt_pk_bf16(g1[2], g1[3]);
                *(u32x4*)rowp = w; }
    }
};

template <class Epi, class Sched, bool ALIGN_EPI = false, bool SP2 = false>
__device__ __forceinline__ void gemm_phase(LAS unsigned char* lds, const Gemm g, const Sched& S, const Epi& E) {
    const int tid = threadIdx.x, wid = __builtin_amdgcn_readfirstlane(tid >> 6), lane = tid & 63, wr = wid >> 2, wc = wid & 3, fr = lane & 15, fq = lane >> 4;
    const int K = g.K, nt = K / BK;
    unsigned voffA[2], voffB[2];
#pragma unroll
    for (int i = 0; i < 2; ++i) { int R, C; stage_rc(tid * 16 + i * 8192, R, C); const int Rb = Epi::PERM ? ((R & ~31) + perm32(R & 31)) : R;
        voffA[i] = (unsigned)(R * K + C) * 2u; voffB[i] = (unsigned)(Rb * K + C) * 2u; }
    const size_t kstep = (size_t)(BK * 2);
    const size_t hstep = (size_t)HALF * K * 2;
    const size_t tstep = 2 * hstep;
    const unsigned ldsw = (unsigned)wid * 1024u;
    const int aoff = lds_byte(wr * 64 + fr, fq * 8), boff = lds_byte(wc * 32 + fr, fq * 8);
#define PG8_SA(b, h) (((b) * 2 + (h)) * HTB)
#define PG8_SB(b, h) ((4 + (b) * 2 + (h)) * HTB)
#define PG8_STAGE(bufoff, gbase, voff) do { _Pragma("unroll") for (int _i = 0; _i < 2; ++_i) \
        __builtin_amdgcn_global_load_lds((const unsigned*)((const char*)(gbase) + (voff)[_i]), (LAS unsigned*)(lds + (bufoff) + ldsw + _i * 8192), 16, 0, 0); } while (0)
#define PG8_LDA(dst, b, h) do { _Pragma("unroll") for (int m = 0; m < 4; ++m) _Pragma("unroll") for (int k = 0; k < 2; ++k) dst[m][k] = *(const LAS bf16x8*)(lds + PG8_SA(b, h) + aoff + m * 2048 + k * 1024); } while (0)
#define PG8_LDB(dst, b, h) do { _Pragma("unroll") for (int n = 0; n < 2; ++n) _Pragma("unroll") for (int k = 0; k < 2; ++k) dst[n][k] = *(const LAS bf16x8*)(lds + PG8_SB(b, h) + boff + n * 2048 + k * 1024); } while (0)
#define PG8_MMA(ai, bj, At, Bt) do { __builtin_amdgcn_s_setprio(1); _Pragma("unroll") for (int m = 0; m < 4; ++m) _Pragma("unroll") for (int n = 0; n < 2; ++n) _Pragma("unroll") for (int k = 0; k < 2; ++k) \
        acc[ai][bj][m][n] = __builtin_amdgcn_mfma_f32_16x16x32_bf16(Bt[n][k], At[m][k], acc[ai][bj][m][n], 0, 0, 0); __builtin_amdgcn_s_setprio(0); } while (0)
#define PG8_WAIT_V(n) asm volatile("s_waitcnt vmcnt(" #n ")" ::: "memory")
#define PG8_WAIT_L(n) asm volatile("s_waitcnt lgkmcnt(" #n ")" ::: "memory")
#define PG8_BAR __builtin_amdgcn_s_barrier()
#define PG8_SCHED __builtin_amdgcn_sched_barrier(0)
    Unit cur, nxt; int ui = 0;
    if (!S.next(0, cur)) return;
    f32x4 acc[2][2][4][2];
#pragma unroll
    for (int a = 0; a < 2; ++a)
#pragma unroll
        for (int b = 0; b < 2; ++b)
#pragma unroll
            for (int m = 0; m < 4; ++m)
#pragma unroll
                for (int n = 0; n < 2; ++n) acc[a][b][m][n] = (f32x4){0.f, 0.f, 0.f, 0.f};
    bf16x8 At[4][2], B0[2][2], B1[2][2];
    const char* cA = (const char*)g.A + (size_t)cur.pm * tstep; const char* cB = (const char*)g.Bt + (size_t)cur.pn * tstep;
    if constexpr (SP2) {
        PG8_STAGE(PG8_SB(0, 0), cB, voffB); PG8_STAGE(PG8_SB(0, 1), cB + hstep, voffB); PG8_STAGE(PG8_SA(0, 0), cA, voffA); PG8_STAGE(PG8_SA(0, 1), cA + hstep, voffA);
        if (wr == 1) PG8_BAR;
        PG8_WAIT_V(2); PG8_BAR;
        PG8_STAGE(PG8_SB(1, 0), cB + kstep, voffB); PG8_STAGE(PG8_SA(1, 0), cA + kstep, voffA); PG8_STAGE(PG8_SB(1, 1), cB + hstep + kstep, voffB);
        PG8_WAIT_V(6); PG8_BAR;
    } else {
        PG8_STAGE(PG8_SB(0, 0), cB, voffB); PG8_STAGE(PG8_SA(0, 0), cA, voffA); PG8_STAGE(PG8_SB(0, 1), cB + hstep, voffB); PG8_STAGE(PG8_SA(0, 1), cA + hstep, voffA);
        if (wr == 1) PG8_BAR;
        PG8_WAIT_V(4); PG8_BAR;
        PG8_STAGE(PG8_SB(1, 0), cB + kstep, voffB); PG8_STAGE(PG8_SA(1, 0), cA + kstep, voffA); PG8_STAGE(PG8_SB(1, 1), cB + hstep + kstep, voffB);
        PG8_WAIT_V(6); PG8_BAR;
    }
    for (;;) {
        const bool has_next = S.next(ui + 1, nxt);
        const char* nA = has_next ? (const char*)g.A + (size_t)nxt.pm * tstep : cA; const char* nB = has_next ? (const char*)g.Bt + (size_t)nxt.pn * tstep : cB;
        for (int t = 0; t < nt; t += 2) {
            if constexpr (Epi::HAS_MID) { if (t == nt / 2) E.mid(acc, cur, wr, wc, fr, fq); }
            const bool last = (t == nt - 2);
            const char* a1 = cA + (size_t)(t + 1) * kstep;
            const char* a2 = last ? nA : cA + (size_t)(t + 2) * kstep; const char* b2 = last ? nB : cB + (size_t)(t + 2) * kstep;
            const char* a3 = a2 + kstep; const char* b3 = b2 + kstep;
            if constexpr (SP2) {
            PG8_LDB(B0, 0, 0); PG8_LDB(B1, 0, 1); PG8_SCHED; PG8_LDA(At, 0, 0); PG8_STAGE(PG8_SA(1, 1), a1 + hstep, voffA);
            PG8_WAIT_V(8); PG8_WAIT_L(0); PG8_BAR; PG8_MMA(0, 0, At, B0); PG8_MMA(0, 1, At, B1); PG8_BAR; PG8_SCHED;
            PG8_LDA(At, 0, 1); PG8_STAGE(PG8_SB(0, 0), b2, voffB); PG8_STAGE(PG8_SB(0, 1), b2 + hstep, voffB); PG8_STAGE(PG8_SA(0, 0), a2, voffA);
            PG8_WAIT_V(8); PG8_WAIT_L(0); PG8_BAR; PG8_MMA(1, 0, At, B0); PG8_MMA(1, 1, At, B1); PG8_BAR; PG8_SCHED;
            PG8_LDB(B0, 1, 0); PG8_LDB(B1, 1, 1); PG8_SCHED; PG8_LDA(At, 1, 0); PG8_STAGE(PG8_SA(0, 1), a2 + hstep, voffA);
            PG8_WAIT_V(8); PG8_WAIT_L(0); PG8_BAR; PG8_MMA(0, 0, At, B0); PG8_MMA(0, 1, At, B1); PG8_BAR; PG8_SCHED;
            PG8_LDA(At, 1, 1); PG8_STAGE(PG8_SB(1, 0), b3, voffB); PG8_STAGE(PG8_SB(1, 1), b3 + hstep, voffB); PG8_STAGE(PG8_SA(1, 0), a3, voffA);
            PG8_WAIT_V(8); PG8_WAIT_L(0); PG8_BAR; PG8_MMA(1, 0, At, B0); PG8_MMA(1, 1, At, B1); PG8_BAR; PG8_SCHED;
            } else {
            PG8_LDB(B0, 0, 0); PG8_SCHED; PG8_LDA(At, 0, 0); PG8_STAGE(PG8_SA(1, 1), a1 + hstep, voffA);
            PG8_WAIT_L(8); PG8_BAR; PG8_WAIT_L(0); PG8_MMA(0, 0, At, B0); PG8_BAR; PG8_SCHED;
            PG8_LDB(B1, 0, 1); PG8_STAGE(PG8_SB(0, 0), b2, voffB);
            PG8_BAR; PG8_WAIT_L(0); PG8_MMA(0, 1, At, B1); PG8_BAR;
            PG8_LDA(At, 0, 1); PG8_STAGE(PG8_SA(0, 0), a2, voffA);
            PG8_BAR; PG8_WAIT_L(0); PG8_MMA(1, 0, At, B0); PG8_BAR; PG8_SCHED;
            PG8_STAGE(PG8_SB(0, 1), b2 + hstep, voffB);
            PG8_WAIT_V(6); PG8_BAR; PG8_MMA(1, 1, At, B1); PG8_BAR;
            PG8_LDB(B0, 1, 0); PG8_SCHED; PG8_LDA(At, 1, 0); PG8_STAGE(PG8_SA(0, 1), a2 + hstep, voffA);
            PG8_WAIT_L(8); PG8_BAR; PG8_WAIT_L(0); PG8_MMA(0, 0, At, B0); PG8_BAR; PG8_SCHED;
            PG8_LDB(B1, 1, 1); PG8_STAGE(PG8_SB(1, 0), b3, voffB);
            PG8_BAR; PG8_WAIT_L(0); PG8_MMA(0, 1, At, B1); PG8_BAR;
            PG8_LDA(At, 1, 1); PG8_STAGE(PG8_SA(1, 0), a3, voffA);
            PG8_BAR; PG8_WAIT_L(0); PG8_MMA(1, 0, At, B0); PG8_BAR; PG8_SCHED;
            PG8_STAGE(PG8_SB(1, 1), b3 + hstep, voffB);
            PG8_WAIT_V(6); PG8_BAR; PG8_MMA(1, 1, At, B1); PG8_BAR;
            }
        }
        if constexpr (ALIGN_EPI) { if (wr == 0) PG8_BAR; }
        E(acc, cur, wr, wc, fr, fq);
        if (!has_next) break;
#pragma unroll
        for (int a = 0; a < 2; ++a)
#pragma unroll
            for (int b = 0; b < 2; ++b)
#pragma unroll
                for (int m = 0; m < 4; ++m)
#pragma unroll
                    for (int n = 0; n < 2; ++n) acc[a][b][m][n] = (f32x4){0.f, 0.f, 0.f, 0.f};
        cur = nxt; cA = nA; cB = nB; ++ui;
        if constexpr (ALIGN_EPI) { if (wr == 1) PG8_BAR; }
    }
    PG8_WAIT_V(0);
    if constexpr (!ALIGN_EPI) { if (wr == 0) PG8_BAR; }
    PG8_BAR;
#undef PG8_SA
#undef PG8_SB
#undef PG8_STAGE
#undef PG8_LDA
#undef PG8_LDB
#undef PG8_MMA
#undef PG8_WAIT_V
#undef PG8_WAIT_L
#undef PG8_BAR
#undef PG8_SCHED
}
}
using pg8::cvt_pk_bf16;

constexpr int NWAVES = 8, NTHR = 512;
constexpr int LDS_BYTES = 147456;

struct Args { const float* in[18]; float* out; unsigned char* ws; int ph_lo, ph_hi; };

#define MFMA32(a, b, c) __builtin_amdgcn_mfma_f32_32x32x16_bf16((a), (b), (c), 0, 0, 0)
__device__ __forceinline__ float wave_sum(float v) {
#pragma unroll
    for (int o = 1; o < 64; o <<= 1) v += __shfl_xor(v, o);
    return v;
}
__device__ __forceinline__ int crow(int i, int h) { return (i & 3) + 8 * (i >> 2) + 4 * h; }
__device__ __forceinline__ int kperm(int r) { return (r & 19) | ((r & 4) << 1) | ((r & 8) >> 1); }

__device__ __forceinline__ void rope_cs(int pos, int i, float& c, float& s) {
    const float inv = exp2f(-(float)i * (13.287712379549449f / 32.0f));
    const float ang = (float)pos * inv;
    double rev = (double)ang * 0.15915494309189535; rev -= floor(rev);
    const float rf = (float)rev;
    c = __builtin_amdgcn_cosf(rf); s = __builtin_amdgcn_sinf(rf);
}

__device__ __forceinline__ void transpose_block(const float* W, int ldw, int srck0, int srccol0, bf16_t* WT, int ldt, int dstrow0, int dstk0, LAS float* scr, int lane, const float* kscale, float kmul, int kmask = 127) {
#pragma unroll 8
    for (int i = 0; i < 32; ++i) { const int kk = 2 * i + (lane >> 5); float v = __builtin_nontemporal_load(W + (size_t)(srck0 + kk) * ldw + srccol0 + (lane & 31));
        if (kscale) v *= kscale[(srck0 + kk) & kmask] * kmul;
        scr[kk * 33 + (lane & 31)] = v; }
    asm volatile("s_waitcnt lgkmcnt(0)" ::: "memory");
    const int c = lane & 7;
#pragma unroll
    for (int j = 0; j < 4; ++j) { const int n = (lane >> 3) + 8 * j; const LAS float* s = scr + (8 * c) * 33 + n;
        u32x4 o; o.x = cvt_pk_bf16(s[0 * 33], s[1 * 33]); o.y = cvt_pk_bf16(s[2 * 33], s[3 * 33]); o.z = cvt_pk_bf16(s[4 * 33], s[5 * 33]); o.w = cvt_pk_bf16(s[6 * 33], s[7 * 33]);
        *(u32x4*)(WT + (size_t)(dstrow0 + n) * ldt + dstk0 + 8 * c) = o; }
    asm volatile("s_waitcnt lgkmcnt(0)" ::: "memory");
}

__device__ __forceinline__ void rms_row_bf16(const float* xrow, const f32x4 (&g)[4], bf16_t* orow, int lane, float eps) {
    const f32x4* xr = (const f32x4*)xrow + lane;
    f32x4 v[4]; float s = 0.f;
#pragma unroll
    for (int j = 0; j < 4; ++j) { v[j] = __builtin_nontemporal_load(xr + 64 * j); s += (v[j].x * v[j].x + v[j].y * v[j].y) + (v[j].z * v[j].z + v[j].w * v[j].w); }
    const float rstd = 1.0f / sqrtf(wave_sum(s) * (1.0f / DM) + eps);
    u32x2* o8 = (u32x2*)orow + lane;
#pragma unroll
    for (int j = 0; j < 4; ++j) { u32x2 w; w.x = cvt_pk_bf16(v[j].x * rstd * g[j].x, v[j].y * rstd * g[j].y); w.y = cvt_pk_bf16(v[j].z * rstd * g[j].z, v[j].w * rstd * g[j].w); o8[64 * j] = w; }
}

__device__ __forceinline__ void rms_rowb_bf16(const bf16_t* xrow, const float* g, bf16_t* orow, int lane, float eps) {
    const u32x4 a = *((const u32x4*)xrow + lane), b = *((const u32x4*)xrow + 64 + lane);
    float v[16]; v[0] = pg8::bf_lo(a.x); v[1] = pg8::bf_hi(a.x); v[2] = pg8::bf_lo(a.y); v[3] = pg8::bf_hi(a.y); v[4] = pg8::bf_lo(a.z); v[5] = pg8::bf_hi(a.z); v[6] = pg8::bf_lo(a.w); v[7] = pg8::bf_hi(a.w);
    v[8] = pg8::bf_lo(b.x); v[9] = pg8::bf_hi(b.x); v[10] = pg8::bf_lo(b.y); v[11] = pg8::bf_hi(b.y); v[12] = pg8::bf_lo(b.z); v[13] = pg8::bf_hi(b.z); v[14] = pg8::bf_lo(b.w); v[15] = pg8::bf_hi(b.w);
    float s = 0.f;
#pragma unroll
    for (int j = 0; j < 16; ++j) s += v[j] * v[j];
    const float rstd = 1.0f / sqrtf(wave_sum(s) * (1.0f / DM) + eps);
    const f32x4 g0 = *(const f32x4*)(g + 8 * lane), g1 = *(const f32x4*)(g + 8 * lane + 4), g2 = *(const f32x4*)(g + 512 + 8 * lane), g3 = *(const f32x4*)(g + 512 + 8 * lane + 4);
    u32x4 o; o.x = cvt_pk_bf16(v[0] * rstd * g0[0], v[1] * rstd * g0[1]); o.y = cvt_pk_bf16(v[2] * rstd * g0[2], v[3] * rstd * g0[3]); o.z = cvt_pk_bf16(v[4] * rstd * g1[0], v[5] * rstd * g1[1]); o.w = cvt_pk_bf16(v[6] * rstd * g1[2], v[7] * rstd * g1[3]);
    *((u32x4*)orow + lane) = o;
    o.x = cvt_pk_bf16(v[8] * rstd * g2[0], v[9] * rstd * g2[1]); o.y = cvt_pk_bf16(v[10] * rstd * g2[2], v[11] * rstd * g2[3]); o.z = cvt_pk_bf16(v[12] * rstd * g3[0], v[13] * rstd * g3[1]); o.w = cvt_pk_bf16(v[14] * rstd * g3[2], v[15] * rstd * g3[3]);
    *((u32x4*)orow + 64 + lane) = o;
}
__device__ __forceinline__ void rms_rowb_f32(const bf16_t* xrow, const float* g, float* orow, int lane, float eps) {
    const u32x4 a = __builtin_nontemporal_load((const u32x4*)xrow + lane), b = __builtin_nontemporal_load((const u32x4*)xrow + 64 + lane);
    float v[16]; v[0] = pg8::bf_lo(a.x); v[1] = pg8::bf_hi(a.x); v[2] = pg8::bf_lo(a.y); v[3] = pg8::bf_hi(a.y); v[4] = pg8::bf_lo(a.z); v[5] = pg8::bf_hi(a.z); v[6] = pg8::bf_lo(a.w); v[7] = pg8::bf_hi(a.w);
    v[8] = pg8::bf_lo(b.x); v[9] = pg8::bf_hi(b.x); v[10] = pg8::bf_lo(b.y); v[11] = pg8::bf_hi(b.y); v[12] = pg8::bf_lo(b.z); v[13] = pg8::bf_hi(b.z); v[14] = pg8::bf_lo(b.w); v[15] = pg8::bf_hi(b.w);
    float s = 0.f;
#pragma unroll
    for (int j = 0; j < 16; ++j) s += v[j] * v[j];
    const float rstd = 1.0f / sqrtf(wave_sum(s) * (1.0f / DM) + eps);
    const f32x4 g0 = *(const f32x4*)(g + 8 * lane), g1 = *(const f32x4*)(g + 8 * lane + 4), g2 = *(const f32x4*)(g + 512 + 8 * lane), g3 = *(const f32x4*)(g + 512 + 8 * lane + 4);
    f32x4* o = (f32x4*)orow;
    __builtin_nontemporal_store((f32x4){v[0], v[1], v[2], v[3]} * rstd * g0, o + 2 * lane); __builtin_nontemporal_store((f32x4){v[4], v[5], v[6], v[7]} * rstd * g1, o + 2 * lane + 1);
    __builtin_nontemporal_store((f32x4){v[8], v[9], v[10], v[11]} * rstd * g2, o + 128 + 2 * lane); __builtin_nontemporal_store((f32x4){v[12], v[13], v[14], v[15]} * rstd * g3, o + 128 + 2 * lane + 1);
}

#define CFENCE() do { asm volatile("" ::: "memory"); __builtin_amdgcn_sched_barrier(0); } while (0)
__device__ __forceinline__ float xhalf_max(float m) {
    auto rr = __builtin_amdgcn_permlane32_swap(__float_as_uint(m), __float_as_uint(m), false, false);
    return fmaxf(__uint_as_float(rr[0]), __uint_as_float(rr[1]));
}
template <bool META, int KB>
__device__ __forceinline__ void da_substep(const LAS unsigned char* kbuf, const LAS unsigned char* vbuf, const int k0x, const int vt, const bf16x8 (&qf0)[4], const LAS unsigned char* q1p,
                                           f32x16 (&O)[2][4], float (&mrun)[2], float (&lrun)[2]) {
#define DA_VF(e, s) (*(const LAS bf16x8*)(vbuf + (e) * 4096 + ((((4 * KB + (s) * 2)) << 4) ^ vt)))
    bf16x8 pf[2][2];
    bf16x8 va0, va1, vb0, vb1;
#pragma unroll
    for (int c = 0; c < 2; ++c) {
        f32x16 x;
        {
            bf16x8 kf[4], q1[4];
#pragma unroll
            for (int ks = 0; ks < 4; ++ks) kf[ks] = *(const LAS bf16x8*)(kbuf + c * 8192 + (k0x ^ (ks * 32)));
            if (c == 1) {
#pragma unroll
                for (int ks = 0; ks < 4; ++ks) q1[ks] = *(const LAS bf16x8*)(q1p + ks * 1024);
            }
            CFENCE();
#pragma unroll
            for (int i = 0; i < 16; ++i) x[i] = 0.f;
#pragma unroll
            for (int ks = 0; ks < 4; ++ks) x = MFMA32(kf[ks], c == 0 ? qf0[ks] : q1[ks], x);
        }
        CFENCE();
        if (c == 1) { va0 = DA_VF(0, 0); va1 = DA_VF(0, 1); vb0 = DA_VF(1, 0); vb1 = DA_VF(1, 1); CFENCE(); }
        if (META) {
#pragma unroll
            for (int i = 8; i < 16; ++i) x[i] = -INFINITY;
        }
        float ra = fmaxf(fmaxf(x[0], x[1]), x[2]); ra = fmaxf(fmaxf(ra, x[3]), x[4]); ra = fmaxf(fmaxf(ra, x[5]), x[6]); ra = fmaxf(fmaxf(ra, x[7]), x[8]);
        float rb = fmaxf(fmaxf(x[9], x[10]), x[11]); rb = fmaxf(fmaxf(rb, x[12]), x[13]); rb = fmaxf(fmaxf(rb, x[14]), x[15]);
        ra = fmaxf(ra, x[15]);
        const float lmx = fmaxf(ra, rb);
        if (__any(lmx > mrun[c])) {
            const float rm = xhalf_max(lmx);
            const float mn = fmaxf(mrun[c], rm + 8.0f); const float al = __builtin_amdgcn_exp2f(mrun[c] - mn); mrun[c] = mn; lrun[c] *= al;
#pragma unroll
            for (int e = 0; e < 4; ++e)
#pragma unroll
                for (int i = 0; i < 16; ++i) O[c][e][i] *= al;
        }
        const float mm = mrun[c]; float sa = 0.f, sb = 0.f;
#pragma unroll
        for (int i = 0; i < 16; i += 2) { x[i] = __builtin_amdgcn_exp2f(x[i] - mm); x[i + 1] = __builtin_amdgcn_exp2f(x[i + 1] - mm); sa += x[i]; sb += x[i + 1]; }
        lrun[c] += sa + sb;
#pragma unroll
        for (int s = 0; s < 2; ++s) { u32x4 p; p.x = cvt_pk_bf16(x[8 * s], x[8 * s + 1]); p.y = cvt_pk_bf16(x[8 * s + 2], x[8 * s + 3]); p.z = cvt_pk_bf16(x[8 * s + 4], x[8 * s + 5]); p.w = cvt_pk_bf16(x[8 * s + 6], x[8 * s + 7]);
            pf[c][s] = __builtin_bit_cast(bf16x8, p); }
        CFENCE();
    }
    O[0][0] = MFMA32(va0, pf[0][0], O[0][0]); O[1][0] = MFMA32(va0, pf[1][0], O[1][0]); O[0][0] = MFMA32(va1, pf[0][1], O[0][0]); O[1][0] = MFMA32(va1, pf[1][1], O[1][0]);
    va0 = DA_VF(2, 0); va1 = DA_VF(2, 1);
    CFENCE();
    O[0][1] = MFMA32(vb0, pf[0][0], O[0][1]); O[1][1] = MFMA32(vb0, pf[1][0], O[1][1]); O[0][1] = MFMA32(vb1, pf[0][1], O[0][1]); O[1][1] = MFMA32(vb1, pf[1][1], O[1][1]);
    vb0 = DA_VF(3, 0); vb1 = DA_VF(3, 1);
    CFENCE();
    O[0][2] = MFMA32(va0, pf[0][0], O[0][2]); O[1][2] = MFMA32(va0, pf[1][0], O[1][2]); O[0][2] = MFMA32(va1, pf[0][1], O[0][2]); O[1][2] = MFMA32(va1, pf[1][1], O[1][2]);
    O[0][3] = MFMA32(vb0, pf[0][0], O[0][3]); O[1][3] = MFMA32(vb0, pf[1][0], O[1][3]); O[0][3] = MFMA32(vb1, pf[0][1], O[0][3]); O[1][3] = MFMA32(vb1, pf[1][1], O[1][3]);
    CFENCE();
#undef DA_VF
}

__device__ __forceinline__ void diff_unit(int b, int h, int qb, const bf16_t* dfQ, const bf16_t* dfK, const bf16_t* VT, const bf16_t* dfKm, const bf16_t* dfVTm,
                                          bf16_t* AO, float lam, LAS unsigned char* lds, int wid, int lane) {
    const int r = lane & 31, hl = lane >> 5;
    const size_t qrow = (size_t)b * SEQ + qb * 256 + wid * 32 + r;
    const int dkey = 8 * wid + (lane >> 3); const int dsc = (lane & 7) ^ ((dkey >> 1) & 7);
    const unsigned kof = (unsigned)(dkey * 512 + (2 * h) * 64 + dsc * 8);
    const int de0 = 8 * wid + (lane >> 3), de1 = de0 + 64;
    const int vsc0 = (lane & 7) ^ ((de0 >> 1) & 7), vsc1 = (lane & 7) ^ ((de1 >> 1) & 7);
    const unsigned vof0_m = (unsigned)((h * 128 + de0) * 64 + vsc0 * 8), vof1_m = (unsigned)((h * 128 + de1) * 64 + vsc1 * 8);
    const unsigned vof0 = (unsigned)(de0 * 64 + vsc0 * 8), vof1 = (unsigned)(de1 * 64 + vsc1 * 8);
    const bf16_t* kbase_r = dfK + (size_t)b * SEQ * 512;
    const bf16_t* vbase_r = VT + (size_t)16777216 + (size_t)((b * 4 + h) * 128) * 8192;
#define DA_DMA(src, dstoff) __builtin_amdgcn_global_load_lds((const unsigned*)(src), (LAS unsigned*)(lds + (dstoff)), 16, 0, 0)
#define DA_ISSUE(t) do { const int bo_ = ((t) & 1) * 32768 + wid * 1024; \
        if ((t) == 0) { DA_DMA(dfKm + kof, bo_); DA_DMA(dfKm + kof + 64, bo_ + 8192); DA_DMA(dfVTm + vof0_m, bo_ + 16384); DA_DMA(dfVTm + vof1_m, bo_ + 16384 + 8192); } \
        else { const bf16_t* kb_ = kbase_r + (size_t)((t) - 1) * 64 * 512; const bf16_t* vb_ = vbase_r + (size_t)((t) - 1) * 8192; \
               DA_DMA(kb_ + kof, bo_); DA_DMA(kb_ + kof + 64, bo_ + 8192); DA_DMA(vb_ + vof0, bo_ + 16384); DA_DMA(vb_ + vof1, bo_ + 16384 + 8192); } } while (0)
    DA_ISSUE(0);
    bf16x8 qf0[4];
    LAS unsigned char* q1p = lds + 65536 + wid * 4096 + lane * 16;
#pragma unroll
    for (int ks = 0; ks < 4; ++ks) { qf0[ks] = *(const bf16x8*)(dfQ + qrow * 512 + (2 * h) * 64 + ks * 16 + hl * 8);
        *(LAS bf16x8*)(q1p + ks * 1024) = *(const bf16x8*)(dfQ + qrow * 512 + (2 * h + 1) * 64 + ks * 16 + hl * 8); }
    const int pk = kperm(r); const int kswz = (pk >> 1) & 7;
    const int k0x = pk * 128 + ((hl ^ kswz) << 4);
    const int vbase = 16384 + r * 128; const int vt = (hl ^ ((r >> 1) & 7)) << 4;
    f32x16 O[2][4];
#pragma unroll
    for (int c = 0; c < 2; ++c)
#pragma unroll
        for (int e = 0; e < 4; ++e)
#pragma unroll
            for (int i = 0; i < 16; ++i) O[c][e][i] = 0.f;
    float mrun[2] = {-1e30f, -1e30f}, lrun[2] = {0.f, 0.f};
    constexpr int NT = 1 + SEQ / 64;
    asm volatile("s_waitcnt vmcnt(0)" ::: "memory");
    __syncthreads();
    DA_ISSUE(1);
    da_substep<true, 0>(lds, lds + vbase, k0x, vt, qf0, q1p, O, mrun, lrun);
    for (int t = 1; t < NT; ++t) {
        asm volatile("s_waitcnt vmcnt(0)" ::: "memory");
        __syncthreads();
        if (t + 1 < NT) DA_ISSUE(t + 1);
        const LAS unsigned char* buf = lds + (t & 1) * 32768;
        da_substep<false, 0>(buf, buf + vbase, k0x, vt, qf0, q1p, O, mrun, lrun);
        da_substep<false, 1>(buf + 4096, buf + vbase, k0x, vt, qf0, q1p, O, mrun, lrun);
    }
    float l0 = lrun[0] + __shfl_xor(lrun[0], 32), l1 = lrun[1] + __shfl_xor(lrun[1], 32);
    const float i0 = 1.0f / l0, i1 = lam / l1;
    float ss = 0.f;
#pragma unroll
    for (int e = 0; e < 4; ++e)
#pragma unroll
        for (int i = 0; i < 16; ++i) { const float o = O[0][e][i] * i0 - O[1][e][i] * i1; O[0][e][i] = o; ss += o * o; }
    ss += __shfl_xor(ss, 32);
    const float rs = 1.0f / sqrtf(ss * (1.0f / 128.0f) + 1e-5f);
    { LAS unsigned char* ost = lds + 98304 + wid * 5120;
      bf16_t* obase = AO + ((size_t)b * SEQ + qb * 256 + wid * 32) * DM + 512 + h * 128;
#pragma unroll
      for (int hf = 0; hf < 2; ++hf) {
#pragma unroll
          for (int e2 = 0; e2 < 2; ++e2)
#pragma unroll
              for (int g = 0; g < 4; ++g) { const int e = 2 * hf + e2; u32x2 w; w.x = cvt_pk_bf16(O[0][e][4 * g] * rs, O[0][e][4 * g + 1] * rs); w.y = cvt_pk_bf16(O[0][e][4 * g + 2] * rs, O[0][e][4 * g + 3] * rs);
                  *(LAS u32x2*)(ost + r * 144 + (32 * e2 + 8 * g + 4 * hl) * 2) = w; }
#pragma unroll
          for (int it = 0; it < 4; ++it) { const int row = 8 * it + (lane >> 3), ch = lane & 7;
              const u32x4 v = *(const LAS u32x4*)(ost + row * 144 + ch * 16);
              *(u32x4*)(obase + (size_t)row * DM + 64 * hf + ch * 8) = v; }
      } }
    __syncthreads();
#undef DA_DMA
#undef DA_ISSUE
}

constexpr int NA_RPB_PAD = 128;
__device__ __forceinline__ void na_softmax_pv(f32x16& x, const bf16x8 (&vf)[2][2], bool meta, f32x16 (&O)[2], float& mrun, float& lrun) {
    float ra = fmaxf(fmaxf(x[0], x[1]), x[2]); ra = fmaxf(fmaxf(ra, x[3]), x[4]); ra = fmaxf(fmaxf(ra, x[5]), x[6]); ra = fmaxf(fmaxf(ra, x[7]), x[8]);
    float rb = fmaxf(fmaxf(x[9], x[10]), x[11]); rb = fmaxf(fmaxf(rb, x[12]), x[13]); rb = fmaxf(fmaxf(rb, x[14]), x[15]);
    ra = fmaxf(ra, x[15]);
    const float lmx = fmaxf(ra, rb);
    if (__any(lmx > mrun)) {
        const float rm = xhalf_max(lmx);
        const float mn = fmaxf(mrun, rm + 8.0f); const float al = __builtin_amdgcn_exp2f(mrun - mn); mrun = mn; lrun *= al;
#pragma unroll
        for (int e = 0; e < 2; ++e)
#pragma unroll
            for (int i = 0; i < 16; ++i) O[e][i] *= al;
    }
    const float mm = mrun; float sa = 0.f, sb = 0.f;
#pragma unroll
    for (int i = 0; i < 16; i += 2) { x[i] = __builtin_amdgcn_exp2f(x[i] - mm); x[i + 1] = __builtin_amdgcn_exp2f(x[i + 1] - mm); sa += x[i]; sb += x[i + 1]; }
    lrun += sa + sb;
    bf16x8 pf[2];
#pragma unroll
    for (int s = 0; s < 2; ++s) { u32x4 p; p.x = cvt_pk_bf16(x[8 * s], x[8 * s + 1]); p.y = cvt_pk_bf16(x[8 * s + 2], x[8 * s + 3]); p.z = cvt_pk_bf16(x[8 * s + 4], x[8 * s + 5]); p.w = cvt_pk_bf16(x[8 * s + 6], x[8 * s + 7]);
        pf[s] = __builtin_bit_cast(bf16x8, p); }
#pragma unroll
    for (int e = 0; e < 2; ++e) { O[e] = MFMA32(vf[e][0], pf[0], O[e]); if (!meta) O[e] = MFMA32(vf[e][1], pf[1], O[e]); }
}

__device__ __forceinline__ void na_unit(int b, int h, int gr, int half, const bf16_t* naQ, const bf16_t* naK, const bf16_t* VT, const bf16_t* naKm, const bf16_t* naVTm,
                                        bf16_t* AO, const LAS float* rpbL, LAS unsigned char* kst, int lane) {
    const int r = lane & 31, hl = lane >> 5;
    const int w = 32 * half + r; const size_t qrow = (size_t)b * SEQ + gr * 64 + w;
    bf16x8 qf[4];
#pragma unroll
    for (int ks = 0; ks < 4; ++ks) qf[ks] = *(const bf16x8*)(naQ + qrow * 512 + h * 64 + ks * 16 + hl * 8);
    const int rs = min(max(gr - 4, 0), 120), c0 = 16 * half, cs = min(max(w - 8, 0), 48);
    const int pk = kperm(r);
    float madd[3][8]; int bofs[3]; int koff[3];
#pragma unroll
    for (int g = 0; g < 3; ++g) { const int cb = c0 + 16 * g + 8 * hl;
#pragma unroll
        for (int j = 0; j < 8; ++j) madd[g][j] = ((unsigned)(cb + j - cs) < 16u) ? 0.f : -INFINITY;
        bofs[g] = (NA_RPB_PAD + h * 465 + cb - w + 15) * 4; }
    int kdo[3][4];
#pragma unroll
    for (int t = 0; t < 3; ++t)
#pragma unroll
        for (int i = 0; i < 4; ++i) { const int rho = 8 * i + (lane >> 3); const int v = 32 * t + kperm(rho); const int q = v >= 48 ? 1 : 0;
            kdo[t][i] = (q * 64 + (v - 48 * q)) * 512 + (((lane & 7) ^ ((rho >> 1) & 7)) << 3); }
    (void)koff; (void)pk;
    const int k0x = r * 128 + ((hl ^ ((r >> 1) & 7)) << 4);
    f32x16 O[2];
#pragma unroll
    for (int e = 0; e < 2; ++e)
#pragma unroll
        for (int i = 0; i < 16; ++i) O[e][i] = 0.f;
    float mrun = -1e30f, lrun = 0.f;
    const LAS unsigned char* rpbB = (const LAS unsigned char*)rpbL;
    const bf16_t* kbase0 = naK + ((size_t)b * SEQ + (size_t)rs * 64 + c0) * 512 + h * 64;
#define NA_KDMA(KK, T, BUF) do { _Pragma("unroll") for (int i_ = 0; i_ < 4; ++i_) \
        __builtin_amdgcn_global_load_lds((const unsigned*)(kbase0 + (size_t)(2 * (KK)) * 64 * 512 + kdo[T][i_]), (LAS unsigned*)(kst + (BUF) * 4096 + i_ * 1024), 16, 0, 0); } while (0)
    const bf16_t* vbase = VT + (size_t)((b * 8 + h) * 128 + rs) * 4096 + half * 1024 + r * 16 + 8 * hl;
    const int browb = (rs - gr + 7) * 31 * 4;
#define NA_GROUP(X, S, G, ROW) do { const LAS unsigned char* bp_ = rpbB + (browb + (ROW) * 124 + bofs[G]); \
        _Pragma("unroll") for (int j_ = 0; j_ < 8; ++j_) X[8 * (S) + j_] = (X[8 * (S) + j_] + *(const LAS float*)(bp_ + 4 * j_)) + madd[G][j_]; } while (0)
#define NA_BLOCK(T, G0, R0, G1, R1, BUF, LAST) do { \
        f32x16 x_; _Pragma("unroll") for (int i_ = 0; i_ < 16; ++i_) x_[i_] = 0.f; \
        bf16x8 vf_[2][2]; \
        _Pragma("unroll") for (int e_ = 0; e_ < 2; ++e_) { vf_[e_][0] = *(const bf16x8*)(vbase + (2 * kk + (R0)) * 4096 + 1024 * (G0) + e_ * 512); vf_[e_][1] = *(const bf16x8*)(vbase + (2 * kk + (R1)) * 4096 + 1024 * (G1) + e_ * 512); } \
        if ((T) < 2) { NA_KDMA(kk, (T) + 1, 1 - (BUF)); asm volatile("s_waitcnt vmcnt(8)" ::: "memory"); } \
        else if (!(LAST)) { NA_KDMA(kk + 1, 0, 1 - (BUF)); asm volatile("s_waitcnt vmcnt(8)" ::: "memory"); } \
        else { asm volatile("s_waitcnt vmcnt(4)" ::: "memory"); } \
        bf16x8 kf_[4]; _Pragma("unroll") for (int ks_ = 0; ks_ < 4; ++ks_) kf_[ks_] = *(const LAS bf16x8*)(kst + (BUF) * 4096 + (k0x ^ (ks_ * 32))); \
        _Pragma("unroll") for (int ks_ = 0; ks_ < 4; ++ks_) x_ = MFMA32(kf_[ks_], qf[ks_], x_); \
        NA_GROUP(x_, 0, G0, 2 * kk + (R0)); NA_GROUP(x_, 1, G1, 2 * kk + (R1)); \
        na_softmax_pv(x_, vf_, false, O, mrun, lrun); } while (0)
    NA_KDMA(0, 0, 0);
    for (int kk = 0; kk < 4; kk += 2) {
        NA_BLOCK(0, 0, 0, 1, 0, 0, false);
        NA_BLOCK(1, 2, 0, 0, 1, 1, false);
        NA_BLOCK(2, 1, 1, 2, 1, 0, false);
        ++kk;
        NA_BLOCK(0, 0, 0, 1, 0, 1, false);
        NA_BLOCK(1, 2, 0, 0, 1, 0, false);
        NA_BLOCK(2, 1, 1, 2, 1, 1, kk == 3);
        --kk;
    }
#undef NA_BLOCK
#undef NA_GROUP
#undef NA_KDMA
    { f32x16 x;
#pragma unroll
      for (int i = 0; i < 16; ++i) x[i] = 0.f;
      bf16x8 vfm[2][2];
#pragma unroll
      for (int e = 0; e < 2; ++e) { vfm[e][0] = *(const bf16x8*)(naVTm + (size_t)(h * 64 + 32 * e + r) * 32 + 8 * hl); vfm[e][1] = vfm[e][0]; }
#pragma unroll
      for (int ks = 0; ks < 4; ++ks) { const bf16x8 kf = *(const bf16x8*)(naKm + (size_t)pk * 512 + h * 64 + hl * 8 + ks * 16); x = MFMA32(kf, qf[ks], x); }
#pragma unroll
      for (int i = 8; i < 16; ++i) x[i] = -INFINITY;
      na_softmax_pv(x, vfm, true, O, mrun, lrun); }
    const float l = lrun + __shfl_xor(lrun, 32); const float il = 1.0f / l;
    { bf16_t* obase = AO + ((size_t)b * SEQ + gr * 64 + 32 * half) * DM + h * 64;
#pragma unroll
      for (int e = 0; e < 2; ++e)
#pragma unroll
          for (int g = 0; g < 4; ++g) { u32x2 wv; wv.x = cvt_pk_bf16(O[e][4 * g] * il, O[e][4 * g + 1] * il); wv.y = cvt_pk_bf16(O[e][4 * g + 2] * il, O[e][4 * g + 3] * il);
              *(LAS u32x2*)(kst + r * 144 + (32 * e + 8 * g + 4 * hl) * 2) = wv; }
#pragma unroll
      for (int it = 0; it < 4; ++it) { const int row = 8 * it + (lane >> 3), ch = lane & 7;
          const u32x4 v = *(const LAS u32x4*)(kst + row * 144 + ch * 16);
          *(u32x4*)(obase + (size_t)row * DM + ch * 8) = v; }
      asm volatile("s_waitcnt lgkmcnt(0)" ::: "memory"); }
}

#define XB_TMO      128
#define XB_XCNT(j)  (256  + 64 * (j))
#define XB_XSUB(j)  (1280 + 64 * (j))
#define XB_XGEN(j)  (2304 + 64 * (j))
#define XB_TOP      3328
#define XB_TOPGEN   3392
#define XCD_BAR_WORDS 3456
#define XB_SPIN_CAP (1u << 18)
__device__ __forceinline__ unsigned xb_ld(unsigned* p)              { return __hip_atomic_load(p, __ATOMIC_RELAXED, __HIP_MEMORY_SCOPE_AGENT); }
__device__ __forceinline__ unsigned xb_add(unsigned* p, unsigned v) { return __hip_atomic_fetch_add(p, v, __ATOMIC_RELAXED, __HIP_MEMORY_SCOPE_AGENT); }
__device__ __forceinline__ unsigned xb_xcc_id() { return (unsigned)__builtin_amdgcn_s_getreg((3 << 11) | 20) & 0xFu; }
#define XB_SPIN(cond, bar) do { unsigned _sp = 0; while (cond) { __builtin_amdgcn_s_sleep(1); \
    if ((++_sp & 255u) == 0u) { if (xb_ld(&(bar)[XB_TMO])) break; if (_sp > XB_SPIN_CAP) { atomicAdd(&(bar)[XB_TMO], 1u); break; } } } } while (0)
struct XcdBarrier { unsigned* bar; unsigned x; volatile LAS unsigned* st; };
__device__ __forceinline__ XcdBarrier xcd_barrier_post(unsigned* bar, volatile LAS unsigned* st) {
    XcdBarrier b; b.bar = bar; b.x = xb_xcc_id(); b.st = st;
    if (threadIdx.x == 0) (void)xb_add(&bar[XB_XCNT(b.x)], 1u);
    return b;
}
__device__ __forceinline__ void xcd_barrier_complete(unsigned* bar, unsigned x, unsigned& nloc, unsigned& nx) {
    const unsigned G = gridDim.x * gridDim.y * gridDim.z;
    unsigned sum, cnt, mine, sp = 0u;
    for (;;) {
        sum = 0u; cnt = 0u; mine = 0u;
#pragma unroll
        for (unsigned j = 0; j < 16; ++j) { const unsigned c = xb_ld(&bar[XB_XCNT(j)]); sum += c; cnt += (c > 0u) ? 1u : 0u; mine = (j == x) ? c : mine; }
        if (sum == G) break;
        __builtin_amdgcn_s_sleep(1);
        if ((++sp & 255u) == 0u) { if (xb_ld(&bar[XB_TMO])) break; if (sp > XB_SPIN_CAP) { atomicAdd(&bar[XB_TMO], 1u); break; } }
    }
    nloc = mine > 0u ? mine : 1u; nx = cnt > 0u ? cnt : 1u;
}
__device__ __forceinline__ void xcd_barrier(const XcdBarrier& b) {
    asm volatile("s_waitcnt vmcnt(0)" ::: "memory");
    __syncthreads();
    if (threadIdx.x == 0) {
        unsigned* bar = b.bar;
        __builtin_amdgcn_s_waitcnt(0);
        unsigned nloc = b.st[0], nx = b.st[1];
        if (nloc == 0u) { xcd_barrier_complete(bar, b.x, nloc, nx); b.st[0] = nloc; b.st[1] = nx; }
        const unsigned old = xb_add(&bar[XB_XSUB(b.x)], 1u);
        const unsigned gen = old / nloc;
        if (old + 1u == (gen + 1u) * nloc) {
            __builtin_amdgcn_fence(__ATOMIC_RELEASE, "agent");
            asm volatile("s_waitcnt vmcnt(0)" ::: "memory");
            const unsigned og = xb_add(&bar[XB_TOP], 1u);
            const unsigned tg = og / nx;
            if (og + 1u == (tg + 1u) * nx) xb_add(&bar[XB_TOPGEN], 1u);
            else XB_SPIN(xb_ld(&bar[XB_TOPGEN]) == tg, bar);
            __builtin_amdgcn_fence(__ATOMIC_ACQUIRE, "agent");
            xb_add(&bar[XB_XGEN(b.x)], 1u);
            asm volatile("s_waitcnt vmcnt(0)" ::: "memory");
        } else {
            XB_SPIN(xb_ld(&bar[XB_XGEN(b.x)]) == gen, bar);
            __builtin_amdgcn_fence(__ATOMIC_ACQUIRE, "agent");
            asm volatile("s_waitcnt vmcnt(0)" ::: "memory");
        }
    }
    __syncthreads();
}

__global__ void __launch_bounds__(NTHR, 2) fwd_megakernel(Args args) {
    extern __shared__ __attribute__((aligned(16))) unsigned char lds_raw[];
    LAS unsigned char* lds = (LAS unsigned char*)lds_raw;
    cg::grid_group grid = cg::this_grid();
    const int tid = threadIdx.x, lane = tid & 63, wid = __builtin_amdgcn_readfirstlane(tid >> 6);
    const int G = gridDim.x, bx = blockIdx.x;
    const int vcu = (G % 8 == 0) ? (bx % 8) * (G / 8) + bx / 8 : bx;
    const int gw = vcu * NWAVES + wid, NGW = G * NWAVES;
    unsigned char* ws = args.ws;
    const float* x = args.in[0]; const float* meta_tokens = args.in[1]; const float* mix_norm = args.in[2]; const float* w_in = args.in[3];
    const float* na_rpb = args.in[4]; const float* lq1 = args.in[5]; const float* lk1 = args.in[6]; const float* lq2 = args.in[7]; const float* lk2 = args.in[8];
    const float* diff_subln = args.in[9]; const float* w_na_out = args.in[10]; const float* w_diff_out = args.in[11]; const float* w_o = args.in[12];
    const float* ffn_norm = args.in[13]; const float* w_gate = args.in[14]; const float* w_up = args.in[15]; const float* w_down = args.in[16]; const float* final_norm = args.in[17];
    bf16_t* WinA = (bf16_t*)(ws + WS_WINA); bf16_t* WinV = (bf16_t*)(ws + WS_WINV); bf16_t* Wm = (bf16_t*)(ws + WS_WM); bf16_t* Wo = (bf16_t*)(ws + WS_WO);
    bf16_t* Wgu = (bf16_t*)(ws + WS_WGU); bf16_t* Wd = (bf16_t*)(ws + WS_WD);
    float* ropeC = (float*)(ws + WS_ROPEC); float* ropeS = (float*)(ws + WS_ROPES);
    bf16_t* naKm = (bf16_t*)(ws + WS_NAKM); bf16_t* dfKm = (bf16_t*)(ws + WS_DFKM); bf16_t* naVTm = (bf16_t*)(ws + WS_NAVTM); bf16_t* dfVTm = (bf16_t*)(ws + WS_DFVTM);
    bf16_t* XN = (bf16_t*)(ws + WS_XN); bf16_t* naQ = (bf16_t*)(ws + WS_NAQ); bf16_t* naK = (bf16_t*)(ws + WS_NAK); bf16_t* dfQ = (bf16_t*)(ws + WS_DFQ); bf16_t* dfK = (bf16_t*)(ws + WS_DFK);
    bf16_t* VT = (bf16_t*)(ws + WS_VT); bf16_t* ACT = (bf16_t*)(ws + WS_ACT); bf16_t* Gna = (bf16_t*)(ws + WS_GNA); bf16_t* Gdf = (bf16_t*)(ws + WS_GDF); bf16_t* AO = (bf16_t*)(ws + WS_AO);
    bf16_t* MG = XN; bf16_t* H2 = XN;
    bf16_t* X1b = Gna; bf16_t* X2b = Gdf;
    float* out = args.out;
    const int lo = args.ph_lo, hi = args.ph_hi;
#define IN(k) (lo <= (k) && (k) < hi)
    volatile LAS unsigned* MISC = (volatile LAS unsigned*)(lds + LDS_BYTES - 64);
    if (tid < 16) MISC[tid] = 0u;
    __syncthreads();
    XcdBarrier xbar = xcd_barrier_post((unsigned*)(ws + WS_CTL), MISC);
    if (args.ph_lo > 1000) grid.sync();
#define SEAM(k) do { if (IN(k) && IN((k) + 1)) xcd_barrier(xbar); } while (0)

    if (IN(0)) {
        {
            LAS float* scr = (LAS float*)(lds + wid * 16384);
            constexpr int I_A = 128 * 16, I_V = 32 * 16, I_M = 32 * 16, I_O = 32 * 16, I_GU = 176 * 16, I_D = 32 * 44;
            constexpr int NITEMS = I_A + I_V + I_M + I_O + I_GU + I_D;
            for (int it = gw; it < NITEMS; it += NGW) {
                int q = it;
                if (q < I_A) { const int kb = q >> 7, nb = q & 127, tile = nb >> 3, bb = nb & 7; int src;
                    if (tile < 4) src = tile * 256 + bb * 32;
                    else if (tile < 8) { const int base = (tile < 6 ? 1536 : 2048) + (tile & 1) * 256; src = base + (bb & 3) * 64 + (bb >> 2) * 32; }
                    else src = (bb < 4 ? 3072 : 4096) + (tile - 8) * 128 + (bb & 3) * 32;
                    transpose_block(w_in, INCOLS, kb * 64, src, WinA, DM, nb * 32, kb * 64, scr, lane, nullptr, 1.f); continue; }
                q -= I_A;
                if (q < I_V) { const int kb = q >> 5, nb = q & 31; const int src = nb < 16 ? 1024 + nb * 32 : 2560 + (nb - 16) * 32;
                    transpose_block(w_in, INCOLS, kb * 64, src, WinV, DM, nb * 32, kb * 64, scr, lane, nullptr, 1.f); continue; }
                q -= I_V;
                if (q < I_M) { const int kb = q >> 5, nb = q & 31;
                    if (kb < 8) transpose_block(w_na_out, DM, kb * 64, nb * 32, Wm, DM, nb * 32, kb * 64, scr, lane, nullptr, 1.f);
                    else transpose_block(w_diff_out, DM, (kb - 8) * 64, nb * 32, Wm, DM, nb * 32, kb * 64, scr, lane, diff_subln, 0.8f);
                    continue; }
                q -= I_M;
                if (q < I_O) { const int kb = q >> 5, nb = q & 31; transpose_block(w_o, DM, kb * 64, nb * 32, Wo, DM, nb * 32, kb * 64, scr, lane, nullptr, 1.f); continue; }
                q -= I_O;
                if (q < I_GU) { const int kb = q / 176, nb = q - kb * 176, tile = nb >> 3, bb = nb & 7;
                    if (bb < 4) transpose_block(w_gate, DFF, kb * 64, tile * 128 + bb * 32, Wgu, DM, nb * 32, kb * 64, scr, lane, ffn_norm, 1.f, 1023);
                    else transpose_block(w_up, DFF, kb * 64, tile * 128 + (bb - 4) * 32, Wgu, DM, nb * 32, kb * 64, scr, lane, ffn_norm, 1.f, 1023);
                    continue; }
                q -= I_GU;
                { const int kb = q >> 5, nb = q & 31; transpose_block(w_down, DM, kb * 64, nb * 32, Wd, DFF, nb * 32, kb * 64, scr, lane, nullptr, 1.f); }
            }
        }
        for (int e = bx * NTHR + tid; e < (SEQ + NMETA) * 32; e += G * NTHR) { float c, s; rope_cs(e >> 5, e & 31, c, s); ropeC[e] = c; ropeS[e] = s; }
        { unsigned* z = (unsigned*)(ws + WS_NAKM); constexpr int NZ = (int)((WS_DFVTM + 64 * 1024 - WS_NAKM) / 4);
          for (int e = bx * NTHR + tid; e < NZ; e += G * NTHR) {
              const size_t byte = (size_t)e * 4 + WS_NAKM; bool valid;
              if (byte < WS_DFKM) valid = (byte - WS_NAKM) < 16 * 1024;
              else if (byte < WS_NAVTM) valid = (byte - WS_DFKM) < 16 * 1024;
              else if (byte < WS_DFVTM) valid = ((byte - WS_NAVTM) & 63) < 32;
              else valid = ((byte - WS_DFVTM) & 127) < 32;
              if (!valid) z[e] = 0u; } }
        __syncthreads();
        {
            LAS float* hmT = (LAS float*)lds;
            LAS float* red = (LAS float*)(lds + 65536);
            for (int rr = 0; rr < 2; ++rr) { const int row = 2 * wid + rr;
                const f32x4* xr = (const f32x4*)(meta_tokens + row * DM) + lane; f32x4 v[4]; float s = 0.f;
#pragma unroll
                for (int j = 0; j < 4; ++j) { v[j] = xr[64 * j]; s += (v[j].x * v[j].x + v[j].y * v[j].y) + (v[j].z * v[j].z + v[j].w * v[j].w); }
                const float rstd = 1.0f / sqrtf(wave_sum(s) * (1.0f / DM) + 1e-6f);
#pragma unroll
                for (int j = 0; j < 4; ++j) { const int k = 4 * lane + 256 * j; const f32x4 g = *(const f32x4*)(mix_norm + k);
                    hmT[(k + 0) * 16 + row] = pg8::bf_lo(cvt_pk_bf16(v[j].x * rstd * g.x, 0.f)); hmT[(k + 1) * 16 + row] = pg8::bf_lo(cvt_pk_bf16(v[j].y * rstd * g.y, 0.f));
                    hmT[(k + 2) * 16 + row] = pg8::bf_lo(cvt_pk_bf16(v[j].z * rstd * g.z, 0.f)); hmT[(k + 3) * 16 + row] = pg8::bf_lo(cvt_pk_bf16(v[j].w * rstd * g.w, 0.f)); } }
            __syncthreads();
            for (int Gc = bx; Gc < 256; Gc += G) {
                const int region = Gc >> 6, gi = Gc & 63, chunk = gi >> 3, sub = gi & 7;
                const int ci = tid & 7, row = (tid >> 3) & 15, kq = tid >> 7;
                const int lcol = chunk * 64 + sub * 4 + (ci & 3) + 32 * (ci >> 2);
                const int rbase = region == 0 ? 512 : region == 1 ? 1024 : region == 2 ? 2048 : 2560;
                const float* wp = w_in + (size_t)(kq * 256) * INCOLS + rbase + lcol;
                float a = 0.f;
#pragma unroll 32
                for (int k = 0; k < 256; ++k) a += hmT[(kq * 256 + k) * 16 + row] * wp[(size_t)k * INCOLS];
                red[(kq * 16 + row) * 8 + ci] = a;
                __syncthreads();
                if (tid < 128) {
                    const int p = ci & 3, hf = ci >> 2;
                    const float v1 = red[(0 * 16 + row) * 8 + p] + red[(1 * 16 + row) * 8 + p] + red[(2 * 16 + row) * 8 + p] + red[(3 * 16 + row) * 8 + p];
                    const float v2 = red[(0 * 16 + row) * 8 + p + 4] + red[(1 * 16 + row) * 8 + p + 4] + red[(2 * 16 + row) * 8 + p + 4] + red[(3 * 16 + row) * 8 + p + 4];
                    float val = hf ? v2 : v1;
                    if (region == 2) { float c, s; rope_cs(row, sub * 4 + p, c, s); val = hf ? (v2 * c + v1 * s) : (v1 * c - v2 * s); }
                    const bf16_t bv = (bf16_t)(cvt_pk_bf16(val, 0.f) & 0xffffu);
                    if (region == 0) naKm[row * 512 + lcol] = bv;
                    else if (region == 1) naVTm[lcol * 32 + row] = bv;
                    else if (region == 2) dfKm[row * 512 + lcol] = bv;
                    else dfVTm[lcol * 64 + row] = bv;
                }
                __syncthreads();
            }
        }
        { f32x4 g[4];
#pragma unroll
          for (int j = 0; j < 4; ++j) g[j] = *((const f32x4*)mix_norm + lane + 64 * j);
          for (int m = gw; m < MTOK; m += NGW) rms_row_bf16(x + (size_t)m * DM, g, XN + (size_t)m * DM, lane, 1e-6f); }
    }
    SEAM(0);

    if (IN(1)) {
        { pg8::Gemm g{XN, WinA, MTOK, 4096, DM}; pg8::StaticOrder S; S.init(MTOK, 4096, G, bx);
          pg8::EpiProj E{naQ, naK, dfQ, dfK, Gna, Gdf, ropeC, ropeS};
          pg8::gemm_phase<pg8::EpiProj, pg8::StaticOrder, true, true>(lds, g, S, E); }
        { pg8::Gemm g{WinV, XN, 1024, MTOK, DM}; pg8::StaticOrder S; S.init(1024, MTOK, G, bx);
          pg8::EpiVT E{VT};
          pg8::gemm_phase<pg8::EpiVT, pg8::StaticOrder, true, true>(lds, g, S, E); }
    }
    SEAM(1);

    if (IN(2)) {
        float lam;
        { const float a = wave_sum(lq1[lane] * lk1[lane]), bb = wave_sum(lq2[lane] * lk2[lane]); lam = expf(a) - expf(bb) + 0.2f; }
        for (int u = 2 * vcu; u < NB * 4 * 32; u += 2 * G) {
            for (int uu = u; uu < u + 2; ++uu) { const int bh = uu >> 5, qb = uu & 31; diff_unit(bh >> 2, bh & 3, qb, dfQ, dfK, VT, dfKm, dfVTm, AO, lam, lds, wid, lane); }
        }
        { LAS float* rpbL = (LAS float*)(lds + 131072);
          for (int e = tid; e < 8 * 465 + 2 * NA_RPB_PAD; e += NTHR) { const int t = e - NA_RPB_PAD; rpbL[e] = (t >= 0 && t < 8 * 465) ? na_rpb[t] * LOG2E : 0.f; }
          __syncthreads();
          for (int u = 4 * vcu; u < 1024; u += 4 * G)
              for (int uu = u; uu < u + 4; ++uu) { const int hq = uu & 1, gr = (uu >> 1) & 127, b = uu >> 8;
                  na_unit(b, hq * 4 + (wid >> 1), gr, wid & 1, naQ, naK, VT, naKm, naVTm, AO, rpbL, lds + wid * 8192, lane); }
          __syncthreads(); }
    }
    SEAM(2);

    if (IN(3)) {
        pg8::Gemm g{AO, Wm, MTOK, DM, DM}; pg8::StaticOrder S; S.init(MTOK, DM, G, bx);
        pg8::EpiMerge E{Gna, Gdf, MG};
        pg8::gemm_phase<pg8::EpiMerge, pg8::StaticOrder, true, true>(lds, g, S, E);
    }
    SEAM(3);

    if (IN(4)) {
        pg8::Gemm g{MG, Wo, MTOK, DM, DM}; pg8::StaticOrder S; S.init(MTOK, DM, G, bx);
        pg8::EpiResidF32toB E{x, X1b};
        pg8::gemm_phase<pg8::EpiResidF32toB, pg8::StaticOrder, true, true>(lds, g, S, E);
    }
    SEAM(4);

    if (IN(5)) {
        float* rstdv = (float*)(ws + WS_RSTD);
        for (int m = gw; m < MTOK; m += NGW) {
            const u32x4 a = *((const u32x4*)(X1b + (size_t)m * DM) + lane), b = *((const u32x4*)(X1b + (size_t)m * DM) + 64 + lane);
            float s = 0.f;
            { const unsigned wv[8] = {a.x, a.y, a.z, a.w, b.x, b.y, b.z, b.w};
#pragma unroll
              for (int j = 0; j < 8; ++j) { const float lo = pg8::bf_lo(wv[j]), hi = pg8::bf_hi(wv[j]); s += lo * lo + hi * hi; } }
            const float tot = wave_sum(s);
            if (lane == 0) rstdv[m] = 1.0f / sqrtf(tot * (1.0f / DM) + 1e-6f);
        }
    }
    SEAM(5);

    if (IN(6)) {
        pg8::Gemm g{X1b, Wgu, MTOK, 2 * DFF, DM}; pg8::StaticOrder S; S.init(MTOK, 2 * DFF, G, bx);
        pg8::EpiSwiGLU E{ACT, (const float*)(ws + WS_RSTD)};
        pg8::gemm_phase<pg8::EpiSwiGLU, pg8::StaticOrder, true, true>(lds, g, S, E);
    }
    SEAM(6);

    if (IN(7)) {
        pg8::Gemm g{ACT, Wd, MTOK, DM, DFF}; pg8::StaticOrder S; S.init(MTOK, DM, G, bx);
        pg8::EpiResidBtoB E{X1b, X2b};
        pg8::gemm_phase<pg8::EpiResidBtoB, pg8::StaticOrder, true, true>(lds, g, S, E);
    }
    SEAM(7);

    if (IN(8)) {
        for (int m = gw; m < MTOK; m += NGW) rms_rowb_f32(X2b + (size_t)m * DM, final_norm, out + (size_t)m * DM, lane, 1e-6f);
    }
#undef IN
#undef SEAM
}

extern "C" void kernel_launch(void* const* d_in, const int* in_sizes, int n_in, void* d_out, int out_size, void* d_ws, size_t ws_size, hipStream_t stream) {
    static int grid = 0;
    if (grid == 0) {
        if (n_in != 18 || out_size != MTOK * DM || ws_size < WS_END) { fprintf(stderr, "kernel_launch: unexpected problem (n_in %d, out %d, ws %zu)\n", n_in, out_size, ws_size); grid = -1; return; }
        int dev = 0, cus = 0, per_cu = 0;
        hipGetDevice(&dev);
        hipDeviceGetAttribute(&cus, hipDeviceAttributeMultiprocessorCount, dev);
        hipFuncSetAttribute((const void*)fwd_megakernel, hipFuncAttributeMaxDynamicSharedMemorySize, LDS_BYTES);
        hipOccupancyMaxActiveBlocksPerMultiprocessor(&per_cu, (const void*)fwd_megakernel, NTHR, LDS_BYTES);
        if (per_cu < 1) { fprintf(stderr, "kernel_launch: occupancy query says %d blocks per CU\n", per_cu); per_cu = 1; }
        (void)hipGetLastError();
        grid = cus;
    }
    if (grid < 0) return;
    if (hipMemsetAsync((char*)d_ws + WS_CTL, 0, CTL_BYTES, stream) != hipSuccess) { fprintf(stderr, "kernel_launch: memset of control words failed\n"); return; }
    Args a{};
    for (int i = 0; i < 18; ++i) a.in[i] = (const float*)d_in[i];
    a.out = (float*)d_out; a.ws = (unsigned char*)d_ws; a.ph_lo = 0; a.ph_hi = 9;
    void* kargs[] = {&a};
    hipError_t e = hipLaunchCooperativeKernel((const void*)fwd_megakernel, dim3(grid), dim3(NTHR), kargs, LDS_BYTES, stream);
    if (e != hipSuccess) fprintf(stderr, "cooperative launch failed: %s (grid %d)\n", hipGetErrorString(e), grid);
}
```
